# Optimizing an MI355X kernel written in HIP

```python
import jax, jax.numpy as jnp
from jax import lax
import numpy as np

D_MODEL = 2048
BATCH = 4
SEQ = 4096
DEPTH = 4

HEAD_DIM = 128
A_WIDTH = D_MODEL // 2
A_HEADS = A_WIDTH // HEAD_DIM
DILATED_PATTERNS = ((128, 1), (512, 4), (2048, 16))
ATTN_BLOCK = 64
ROPE_THETA = 10000.0
NEG_INF = -1e30
B_WIDTH = D_MODEL // 2
B_CONV = 3
C_WIDTH = D_MODEL
C_GROUPS = 8
C_CHUNK = 128
AB_IN_WIDTH = 4 * A_WIDTH + 4 * B_WIDTH
SG_IN_WIDTH = 3 * C_WIDTH
N_EVEN = (DEPTH + 1) // 2
N_ODD = DEPTH // 2
EPS = 1e-6

kernel_name = 'hybrid_dilated_attn_shortconv_sgu_adaln'


def rms_norm(x, g):
    xf = x.astype(jnp.float32)
    y = xf * lax.rsqrt(jnp.mean(xf * xf, axis=-1, keepdims=True) + EPS)
    return (y * g.astype(jnp.float32)).astype(x.dtype)


def layer_norm(x, g, b):
    xf = x.astype(jnp.float32)
    mu = jnp.mean(xf, axis=-1, keepdims=True)
    xc = xf - mu
    y = xc * lax.rsqrt(jnp.mean(xc * xc, axis=-1, keepdims=True) + EPS)
    return (y * g.astype(jnp.float32) + b.astype(jnp.float32)).astype(x.dtype)


def ada_modulation(c, w_mod, b_mod):
    m = jax.nn.silu(c) @ w_mod + b_mod
    shift, scale, gate = jnp.split(m, 3, axis=-1)
    return shift[:, None, :], scale[:, None, :], gate[:, None, :]


def rope(t, pos):
    half = t.shape[-1] // 2
    inv = ROPE_THETA ** (-jnp.arange(half, dtype=jnp.float32) / half)
    ang = pos[:, None] * inv[None, :]
    cos = jnp.cos(ang)[None, :, None, :]
    sin = jnp.sin(ang)[None, :, None, :]
    tf = t.astype(jnp.float32)
    t1, t2 = tf[..., :half], tf[..., half:]
    out = jnp.concatenate([t1 * cos - t2 * sin, t2 * cos + t1 * sin], axis=-1)
    return out.astype(t.dtype)


def dilated_window_attention(q, k, v, dilation, radius):
    b, h, s, hd = q.shape
    sub_len = s // dilation
    n_blk = -(-sub_len // ATTN_BLOCK)
    lp = n_blk * ATTN_BLOCK
    pad = lp - sub_len

    def to_sub(t):
        return t.reshape(b, h, sub_len, dilation, hd).transpose(0, 1, 3, 2, 4)

    qs = jnp.pad(to_sub(q), ((0, 0), (0, 0), (0, 0), (0, pad), (0, 0)))
    qb = qs.reshape(b, h, dilation, n_blk, ATTN_BLOCK, hd)
    halo = ((0, 0), (0, 0), (0, 0), (ATTN_BLOCK, pad + ATTN_BLOCK), (0, 0))
    kp = jnp.pad(to_sub(k), halo)
    vp = jnp.pad(to_sub(v), halo)

    def band(t):
        return jnp.concatenate(
            [t[:, :, :, o:o + lp].reshape(b, h, dilation, n_blk, ATTN_BLOCK, hd)
             for o in (0, ATTN_BLOCK, 2 * ATTN_BLOCK)], axis=-2)

    kb, vb = band(kp), band(vp)
    blk = jnp.arange(n_blk)[:, None, None] * ATTN_BLOCK
    q_idx = blk + jnp.arange(ATTN_BLOCK)[None, :, None]
    k_idx = blk - ATTN_BLOCK + jnp.arange(3 * ATTN_BLOCK)[None, None, :]
    valid = (jnp.abs(q_idx - k_idx) <= radius) & (k_idx >= 0) & (k_idx < sub_len)

    scores = jnp.einsum('bhrnqd,bhrnkd->bhrnqk', qb, kb,
                        preferred_element_type=jnp.float32) * (hd ** -0.5)
    scores = jnp.where(valid, scores, NEG_INF)
    m = jnp.max(scores, axis=-1, keepdims=True)
    p = jnp.exp(scores - m)
    den = jnp.sum(p, axis=-1, keepdims=True)
    o = jnp.einsum('bhrnqk,bhrnkd->bhrnqd', p, vb.astype(jnp.float32)) / den
    lse = (m + jnp.log(den))[..., 0]
    o = o.reshape(b, h, dilation, lp, hd)[:, :, :, :sub_len]
    o = o.transpose(0, 1, 3, 2, 4).reshape(b, h, s, hd)
    lse = lse.reshape(b, h, dilation, lp)[..., :sub_len].transpose(0, 1, 3, 2).reshape(b, h, s)
    return o, lse


def dilated_mixture_attention(q, k, v):
    outs, lses = [], []
    for window, dilation in DILATED_PATTERNS:
        o, lse = dilated_window_attention(q, k, v, dilation, window // (2 * dilation))
        outs.append(o)
        lses.append(lse)
    w = jax.nn.softmax(jnp.stack(lses, axis=0), axis=0)
    return jnp.einsum('pbhs,pbhsd->bhsd', w, jnp.stack(outs, axis=0))


def short_conv(u, w):
    return lax.conv_general_dilated(
        u, w[:, None, :].astype(u.dtype), window_strides=(1,), padding=((1, 1),),
        dimension_numbers=('NWC', 'WIO', 'NWC'), feature_group_count=u.shape[-1])


def mixer_ab(h, w_in, conv_w, w_out):
    b, s, _ = h.shape
    proj = h @ w_in
    cuts = np.cumsum([A_WIDTH] * 4 + [B_WIDTH] * 3).tolist()
    q, k, v, z_a, u_b, g_b, g_c, z_b = jnp.split(proj, cuts, axis=-1)
    pos = jnp.arange(s, dtype=jnp.float32)
    q = rope(q.reshape(b, s, A_HEADS, HEAD_DIM), pos).transpose(0, 2, 1, 3)
    k = rope(k.reshape(b, s, A_HEADS, HEAD_DIM), pos).transpose(0, 2, 1, 3)
    v = v.reshape(b, s, A_HEADS, HEAD_DIM).transpose(0, 2, 1, 3)
    attn = dilated_mixture_attention(q, k, v)
    y_a = attn.transpose(0, 2, 1, 3).reshape(b, s, A_WIDTH).astype(h.dtype) * jax.nn.silu(z_a)
    y_b = g_b * short_conv(g_c * u_b, conv_w) * jax.nn.silu(z_b)
    return jnp.concatenate([y_a, y_b], axis=-1) @ w_out


def mixer_sgu(h, w_in, ln_g, ln_b, w_s, b_s, w_out):
    b, s, _ = h.shape
    u, v, z = jnp.split(h @ w_in, 3, axis=-1)
    u = jax.nn.gelu(u)
    v = layer_norm(jax.nn.gelu(v), ln_g, ln_b)
    v = v.reshape(b, s // C_CHUNK, C_CHUNK, C_GROUPS, C_WIDTH // C_GROUPS)
    mixed = jnp.einsum('gts,bnsgc->bntgc', w_s, v) + b_s.T[None, None, :, :, None]
    y = u * mixed.reshape(b, s, C_WIDTH) * jax.nn.silu(z)
    return y @ w_out


def setup_inputs(seed: int = 0) -> dict:
    key = jax.random.key(seed)
    ks = jax.random.split(key, 20)
    D = D_MODEL

    def nrm(k, shape, scale):
        return jax.random.normal(k, shape, jnp.float32) * scale

    return {
        'x': nrm(ks[0], (BATCH, SEQ, D), 1.0),
        'c': nrm(ks[1], (BATCH, D), 1.0),
        'ab_norm_g': 1.0 + nrm(ks[2], (N_EVEN, D), 0.02),
        'ab_w_mod': nrm(ks[3], (N_EVEN, D, 3 * D), 0.5 * D ** -0.5),
        'ab_b_mod': nrm(ks[4], (N_EVEN, 3 * D), 0.01),
        'ab_w_in': nrm(ks[5], (N_EVEN, D, AB_IN_WIDTH), D ** -0.5),
        'ab_conv_w': nrm(ks[6], (N_EVEN, B_CONV, B_WIDTH), B_CONV ** -0.5),
        'ab_w_out': nrm(ks[7], (N_EVEN, A_WIDTH + B_WIDTH, D), (A_WIDTH + B_WIDTH) ** -0.5),
        'sg_norm_g': 1.0 + nrm(ks[8], (N_ODD, D), 0.02),
        'sg_w_mod': nrm(ks[9], (N_ODD, D, 3 * D), 0.5 * D ** -0.5),
        'sg_b_mod': nrm(ks[10], (N_ODD, 3 * D), 0.01),
        'sg_w_in': nrm(ks[11], (N_ODD, D, SG_IN_WIDTH), D ** -0.5),
        'sg_ln_g': 1.0 + nrm(ks[12], (N_ODD, C_WIDTH), 0.02),
        'sg_ln_b': nrm(ks[13], (N_ODD, C_WIDTH), 0.01),
        'sg_w_s': nrm(ks[14], (N_ODD, C_GROUPS, C_CHUNK, C_CHUNK), C_CHUNK ** -0.5),
        'sg_b_s': 1.0 + nrm(ks[15], (N_ODD, C_GROUPS, C_CHUNK), 0.01),
        'sg_w_out': nrm(ks[16], (N_ODD, C_WIDTH, D), C_WIDTH ** -0.5),
        'final_norm_g': 1.0 + nrm(ks[17], (D,), 0.02),
    }


def reference(x, c, ab_norm_g, ab_w_mod, ab_b_mod, ab_w_in, ab_conv_w, ab_w_out,
              sg_norm_g, sg_w_mod, sg_b_mod, sg_w_in, sg_ln_g, sg_ln_b, sg_w_s, sg_b_s,
              sg_w_out, final_norm_g):
    for layer in range(DEPTH):
        i = layer // 2
        if layer % 2 == 0:
            shift, scale, gate = ada_modulation(c, ab_w_mod[i], ab_b_mod[i])
            h = rms_norm(x, ab_norm_g[i]) * (1.0 + scale) + shift
            out = mixer_ab(h, ab_w_in[i], ab_conv_w[i], ab_w_out[i])
        else:
            shift, scale, gate = ada_modulation(c, sg_w_mod[i], sg_b_mod[i])
            h = rms_norm(x, sg_norm_g[i]) * (1.0 + scale) + shift
            out = mixer_sgu(h, sg_w_in[i], sg_ln_g[i], sg_ln_b[i], sg_w_s[i], sg_b_s[i], sg_w_out[i])
        x = x + gate * out
    return rms_norm(x, final_norm_g)
```

```cpp
#include <hip/hip_runtime.h>
#include <hip/hip_cooperative_groups.h>
#include <cstdio>
#include <cstdint>
namespace cg = cooperative_groups;
namespace pg8 {
#define PG8_LAS __attribute__((address_space(3)))
typedef unsigned short bf16_t;
typedef short bf16x8 __attribute__((ext_vector_type(8)));
typedef float f32x4 __attribute__((ext_vector_type(4)));
typedef unsigned u32x4 __attribute__((ext_vector_type(4)));
constexpr int BM = 256, BK = 64, HALF = 128, HTB = HALF * BK * 2  , STAGE_BYTES = 8 * HTB, NXCD = 8, WGM = 8;

__host__ __device__ __forceinline__ int lds_byte(int r, int c) { const int st = (r >> 4) * 2 + (c >> 5), rr = r & 15, cc = c & 31, ob = rr * 64 + cc * 2; return st * 1024 + (ob ^ (((ob >> 9) & 1) << 5)); }
__host__ __device__ __forceinline__ void stage_rc(int b, int& R, int& C) { const int st = b / 1024, sb = b % 1024, swz = sb ^ (((sb >> 9) & 1) << 5); R = (st >> 1) * 16 + swz / 64; C = (st & 1) * 32 + (swz % 64) / 2; }
__host__ __device__ __forceinline__ int perm32(int rho) { const int n = rho >> 4, i = rho & 15; return 8 * (i >> 2) + 4 * n + (i & 3); }

struct Unit { int pm, pn; };
struct Gemm { const bf16_t* A; const bf16_t* Bt; int M, N, K, pm_mask; };

struct StaticOrder {
    int nM, nN, nwg, G, c;
    __host__ __device__ void init(int M, int N, int G_, int c_) { nM = M / BM; nN = N / BM; nwg = nM * nN; G = G_; c = c_; }
    __host__ __device__ bool next(int i, Unit& u) const {
        const long L = (long)i * G + c; if (L >= nwg) return false;
        int wgid = (int)L; { const int q = nwg / NXCD, r = nwg % NXCD, xcd = wgid % NXCD, off = wgid / NXCD; wgid = (xcd < r ? xcd * (q + 1) : r * (q + 1) + (xcd - r) * q) + off; }
        const int nig = WGM * nN, gid = wgid / nig, fm = gid * WGM, gsz = (nM - fm) < WGM ? (nM - fm) : WGM;
        u.pm = fm + ((wgid % nig) % gsz); u.pn = (wgid % nig) / gsz; return true;
    }
    __device__ __forceinline__ void a_ready(const Unit&) const {}
    __device__ __forceinline__ void done(const Unit&) const {}
};

__device__ __forceinline__ unsigned cvt_pk_bf16(float lo, float hi) { unsigned r; asm volatile("v_cvt_pk_bf16_f32 %0, %1, %2" : "=v"(r) : "v"(lo), "v"(hi)); return r; }
template <class Epi, class Sched, bool ALIGN_EPI = false, bool SP2 = false>
__device__ __forceinline__ void gemm_phase(PG8_LAS unsigned char* lds, const Gemm g, const Sched& S, const Epi& E) {
    int tid_ = threadIdx.x; asm volatile("" : "+v"(tid_));
    const int tid = tid_, wid = __builtin_amdgcn_readfirstlane(tid >> 6), lane = tid & 63, wr = wid >> 2, wc = wid & 3, fr = lane & 15, fq = lane >> 4;
    const int K = g.K, nt = K / BK;
    unsigned voffA[2], voffB[2];
#pragma unroll
    for (int i = 0; i < 2; ++i) { int R, C; stage_rc(tid * 16 + i * 8192, R, C); const int Rb = Epi::PERM ? ((R & ~31) + perm32(R & 31)) : R;
        voffA[i] = (unsigned)(R * K + C) * 2u; voffB[i] = (unsigned)(Rb * K + C) * 2u; }
    const size_t kstep = (size_t)(BK * 2);
    const size_t hstep = (size_t)HALF * K * 2;
    const size_t tstep = 2 * hstep;
    const unsigned ldsw = (unsigned)wid * 1024u;
    const int aoff = lds_byte(wr * 64 + fr, fq * 8), boff = lds_byte(wc * 32 + fr, fq * 8);
#define PG8_SA(b, h) (((b) * 2 + (h)) * HTB)
#define PG8_SB(b, h) ((4 + (b) * 2 + (h)) * HTB)
#define PG8_STAGE(bufoff, gbase, voff) do { _Pragma("unroll") for (int _i = 0; _i < 2; ++_i) \
        __builtin_amdgcn_global_load_lds((const unsigned*)((const char*)(gbase) + (voff)[_i]), (PG8_LAS unsigned*)(lds + (bufoff) + ldsw + _i * 8192), 16, 0, 0); } while (0)
#define PG8_LDA(dst, b, h) do { _Pragma("unroll") for (int m = 0; m < 4; ++m) _Pragma("unroll") for (int k = 0; k < 2; ++k) dst[m][k] = *(const PG8_LAS bf16x8*)(lds + PG8_SA(b, h) + aoff + m * 2048 + k * 1024); } while (0)
#define PG8_LDB(dst, b, h) do { _Pragma("unroll") for (int n = 0; n < 2; ++n) _Pragma("unroll") for (int k = 0; k < 2; ++k) dst[n][k] = *(const PG8_LAS bf16x8*)(lds + PG8_SB(b, h) + boff + n * 2048 + k * 1024); } while (0)
#define PG8_MMA(ai, bj, At, Bt) do { __builtin_amdgcn_s_setprio(1); _Pragma("unroll") for (int m = 0; m < 4; ++m) _Pragma("unroll") for (int n = 0; n < 2; ++n) _Pragma("unroll") for (int k = 0; k < 2; ++k) \
        acc[ai][bj][m][n] = __builtin_amdgcn_mfma_f32_16x16x32_bf16(Bt[n][k], At[m][k], acc[ai][bj][m][n], 0, 0, 0); __builtin_amdgcn_s_setprio(0); } while (0)
#define PG8_WAIT_V(n) asm volatile("s_waitcnt vmcnt(" #n ")" ::: "memory")
#define PG8_WAIT_L(n) asm volatile("s_waitcnt lgkmcnt(" #n ")" ::: "memory")
#define PG8_BAR __builtin_amdgcn_s_barrier()
#define PG8_SCHED __builtin_amdgcn_sched_barrier(0)
    Unit cur, nxt; int ui = 0;
    if (!S.next(0, cur)) return;
    f32x4 acc[2][2][4][2];
#pragma unroll
    for (int a = 0; a < 2; ++a)
#pragma unroll
        for (int b = 0; b < 2; ++b)
#pragma unroll
            for (int m = 0; m < 4; ++m)
#pragma unroll
                for (int n = 0; n < 2; ++n) acc[a][b][m][n] = (f32x4){0.f, 0.f, 0.f, 0.f};
    bf16x8 At[4][2], B0[2][2], B1[2][2];
    const char* cA = (const char*)g.A + (size_t)(cur.pm & g.pm_mask) * tstep; const char* cB = (const char*)g.Bt + (size_t)cur.pn * tstep;
    S.a_ready(cur);
    if constexpr (SP2) {
        PG8_STAGE(PG8_SB(0, 0), cB, voffB); PG8_STAGE(PG8_SB(0, 1), cB + hstep, voffB); PG8_STAGE(PG8_SA(0, 0), cA, voffA); PG8_STAGE(PG8_SA(0, 1), cA + hstep, voffA);
        if (wr == 1) PG8_BAR;
        PG8_WAIT_V(2); PG8_BAR;
        PG8_STAGE(PG8_SB(1, 0), cB + kstep, voffB); PG8_STAGE(PG8_SA(1, 0), cA + kstep, voffA); PG8_STAGE(PG8_SB(1, 1), cB + hstep + kstep, voffB);
        PG8_WAIT_V(6); PG8_BAR;
    } else {
        PG8_STAGE(PG8_SB(0, 0), cB, voffB); PG8_STAGE(PG8_SA(0, 0), cA, voffA); PG8_STAGE(PG8_SB(0, 1), cB + hstep, voffB); PG8_STAGE(PG8_SA(0, 1), cA + hstep, voffA);
        if (wr == 1) PG8_BAR;
        PG8_WAIT_V(4); PG8_BAR;
        PG8_STAGE(PG8_SB(1, 0), cB + kstep, voffB); PG8_STAGE(PG8_SA(1, 0), cA + kstep, voffA); PG8_STAGE(PG8_SB(1, 1), cB + hstep + kstep, voffB);
        PG8_WAIT_V(6); PG8_BAR;
    }
    for (;;) {
        const bool has_next = S.next(ui + 1, nxt);
        const char* nA = has_next ? (const char*)g.A + (size_t)(nxt.pm & g.pm_mask) * tstep : cA; const char* nB = has_next ? (const char*)g.Bt + (size_t)nxt.pn * tstep : cB;
        for (int t = 0; t < nt; t += 2) {
            const bool last = (t == nt - 2);
            const char* a1 = cA + (size_t)(t + 1) * kstep;
            const char* a2 = last ? nA : cA + (size_t)(t + 2) * kstep; const char* b2 = last ? nB : cB + (size_t)(t + 2) * kstep;
            const char* a3 = a2 + kstep; const char* b3 = b2 + kstep;
            if (last && has_next) S.a_ready(nxt);
            if constexpr (SP2) {
            PG8_LDB(B0, 0, 0); PG8_LDB(B1, 0, 1); PG8_SCHED; PG8_LDA(At, 0, 0); PG8_STAGE(PG8_SA(1, 1), a1 + hstep, voffA);
            PG8_WAIT_V(8); PG8_WAIT_L(0); PG8_BAR; PG8_MMA(0, 0, At, B0); PG8_MMA(0, 1, At, B1); PG8_BAR; PG8_SCHED;
            PG8_LDA(At, 0, 1); PG8_STAGE(PG8_SB(0, 0), b2, voffB); PG8_STAGE(PG8_SB(0, 1), b2 + hstep, voffB); PG8_STAGE(PG8_SA(0, 0), a2, voffA);
            PG8_WAIT_V(8); PG8_WAIT_L(0); PG8_BAR; PG8_MMA(1, 0, At, B0); PG8_MMA(1, 1, At, B1); PG8_BAR; PG8_SCHED;
            PG8_LDB(B0, 1, 0); PG8_LDB(B1, 1, 1); PG8_SCHED; PG8_LDA(At, 1, 0); PG8_STAGE(PG8_SA(0, 1), a2 + hstep, voffA);
            PG8_WAIT_V(8); PG8_WAIT_L(0); PG8_BAR; PG8_MMA(0, 0, At, B0); PG8_MMA(0, 1, At, B1); PG8_BAR; PG8_SCHED;
            PG8_LDA(At, 1, 1); PG8_STAGE(PG8_SB(1, 0), b3, voffB); PG8_STAGE(PG8_SB(1, 1), b3 + hstep, voffB); PG8_STAGE(PG8_SA(1, 0), a3, voffA);
            PG8_WAIT_V(8); PG8_WAIT_L(0); PG8_BAR; PG8_MMA(1, 0, At, B0); PG8_MMA(1, 1, At, B1); PG8_BAR; PG8_SCHED;
            } else {
            PG8_LDB(B0, 0, 0); PG8_SCHED; PG8_LDA(At, 0, 0); PG8_STAGE(PG8_SA(1, 1), a1 + hstep, voffA);
            PG8_WAIT_L(8); PG8_BAR; PG8_WAIT_L(0); PG8_MMA(0, 0, At, B0); PG8_BAR; PG8_SCHED;
            PG8_LDB(B1, 0, 1); PG8_STAGE(PG8_SB(0, 0), b2, voffB);
            PG8_BAR; PG8_WAIT_L(0); PG8_MMA(0, 1, At, B1); PG8_BAR;
            PG8_LDA(At, 0, 1); PG8_STAGE(PG8_SA(0, 0), a2, voffA);
            PG8_BAR; PG8_WAIT_L(0); PG8_MMA(1, 0, At, B0); PG8_BAR; PG8_SCHED;
            PG8_STAGE(PG8_SB(0, 1), b2 + hstep, voffB);
            PG8_WAIT_V(6); PG8_BAR; PG8_MMA(1, 1, At, B1); PG8_BAR;
            PG8_LDB(B0, 1, 0); PG8_SCHED; PG8_LDA(At, 1, 0); PG8_STAGE(PG8_SA(0, 1), a2 + hstep, voffA);
            PG8_WAIT_L(8); PG8_BAR; PG8_WAIT_L(0); PG8_MMA(0, 0, At, B0); PG8_BAR; PG8_SCHED;
            PG8_LDB(B1, 1, 1); PG8_STAGE(PG8_SB(1, 0), b3, voffB);
            PG8_BAR; PG8_WAIT_L(0); PG8_MMA(0, 1, At, B1); PG8_BAR;
            PG8_LDA(At, 1, 1); PG8_STAGE(PG8_SA(1, 0), a3, voffA);
            PG8_BAR; PG8_WAIT_L(0); PG8_MMA(1, 0, At, B0); PG8_BAR; PG8_SCHED;
            PG8_STAGE(PG8_SB(1, 1), b3 + hstep, voffB);
            PG8_WAIT_V(6); PG8_BAR; PG8_MMA(1, 1, At, B1); PG8_BAR;
            }
        }
        if constexpr (ALIGN_EPI) { if (wr == 0) PG8_BAR; }
        if constexpr (!Epi::AFTER_DRAIN) { E(acc, cur, wr, wc, fr, fq); S.done(cur); }
        if (!has_next) break;
#pragma unroll
        for (int a = 0; a < 2; ++a)
#pragma unroll
            for (int b = 0; b < 2; ++b)
#pragma unroll
                for (int m = 0; m < 4; ++m)
#pragma unroll
                    for (int n = 0; n < 2; ++n) acc[a][b][m][n] = (f32x4){0.f, 0.f, 0.f, 0.f};
        cur = nxt; cA = nA; cB = nB; ++ui;
        if constexpr (ALIGN_EPI) { if (wr == 1) PG8_BAR; }
    }
    PG8_WAIT_V(0);
    if constexpr (!ALIGN_EPI) { if (wr == 0) PG8_BAR; }
    PG8_BAR;
    if constexpr (Epi::AFTER_DRAIN) { E.fused(acc, cur, wr, wc, fr, fq, lds, wid, lane); S.done(cur); }
#undef PG8_SA
#undef PG8_SB
#undef PG8_STAGE
#undef PG8_LDA
#undef PG8_LDB
#undef PG8_MMA
#undef PG8_WAIT_V
#undef PG8_WAIT_L
#undef PG8_BAR
#undef PG8_SCHED
}
}

#define LAS __attribute__((address_space(3)))
typedef unsigned short bf16_t;
typedef short bf16x8 __attribute__((ext_vector_type(8)));
typedef float f32x4 __attribute__((ext_vector_type(4)));
typedef float f32x16 __attribute__((ext_vector_type(16)));
typedef unsigned u32x4 __attribute__((ext_vector_type(4)));
typedef unsigned u32x2 __attribute__((ext_vector_type(2)));
typedef unsigned short u16x4 __attribute__((ext_vector_type(4)));

constexpr int DM = 2048, NB = 4, SEQ = 4096, MTOK = NB * SEQ;
constexpr int AW = 1024;
constexpr int N_AB = 8192, N_SG = 6144;
constexpr int NWAVES = 8, NTHR = 512;
constexpr int LDS_BYTES = 135168;
constexpr int LDS_XB = LDS_BYTES - 16;
constexpr float QSCALE = 0.08838834764831845f * 1.4426950408889634f;
constexpr float LN2F = 0.6931471805599453f;

constexpr size_t SZ_WAB_IN = (size_t)N_AB * DM * 2, SZ_WOUT = (size_t)DM * DM * 2, SZ_WSG_IN = (size_t)N_SG * DM * 2;
constexpr size_t WS_WAB_IN = 0;
constexpr size_t WS_WAB_OUT = WS_WAB_IN + 2 * SZ_WAB_IN;
constexpr size_t WS_WSG_IN = WS_WAB_OUT + 2 * SZ_WOUT;
constexpr size_t WS_WSG_OUT = WS_WSG_IN + 2 * SZ_WSG_IN;
constexpr size_t WS_WS = WS_WSG_OUT + 2 * SZ_WOUT;
constexpr size_t WS_MOD = WS_WS + (size_t)2 * 8 * 128 * 128 * 2;
constexpr size_t SZ_MOD = (size_t)4 * 4 * 6144 * 4;
constexpr size_t WS_BAR = WS_MOD + SZ_MOD;
constexpr size_t SZ_BAR = 16384;
constexpr size_t WS_ROPE = WS_BAR + SZ_BAR;
constexpr size_t WS_STATS = WS_ROPE + (size_t)2 * 4096 * 64 * 4;
constexpr size_t WS_H = WS_STATS + (size_t)MTOK * 32 * 8;
constexpr size_t SZ_ACT = (size_t)MTOK * DM * 2;
constexpr size_t WS_P = WS_H + SZ_ACT;
constexpr size_t SZ_A = (size_t)MTOK * AW * 2;
constexpr size_t WS_Q = WS_P, WS_K = WS_P + SZ_A, WS_V = WS_P + 2 * SZ_A, WS_SZA = WS_P + 3 * SZ_A, WS_PP = WS_P + 4 * SZ_A, WS_GZ = WS_P + 5 * SZ_A;
constexpr size_t WS_OP = WS_P + 6 * SZ_A;
constexpr size_t WS_LSE = WS_OP + 3 * SZ_A;
constexpr size_t WS_END = WS_LSE + (size_t)3 * MTOK * 8 * 4;
constexpr size_t WS_DL = WS_P;
constexpr size_t WS_UZ = WS_P, WS_GV = WS_P + SZ_ACT;

struct Params {
    const float* in[18];
    float* out;
    unsigned char* ws;
    int ph_lo, ph_hi;
};
__device__ __forceinline__ const float* inp(const Params& P, int i) { asm volatile("" : "+s"(i)); return P.in[i]; }
enum { I_X = 0, I_C, I_AB_NG, I_AB_WMOD, I_AB_BMOD, I_AB_WIN, I_AB_CONV, I_AB_WOUT, I_SG_NG, I_SG_WMOD, I_SG_BMOD, I_SG_WIN, I_SG_LNG, I_SG_LNB, I_SG_WS, I_SG_BS, I_SG_WOUT, I_FNG };

__device__ const double kInvFreq[64] = {
1.0, 0.8659643233600653, 0.7498942093324559, 0.6493816315762113, 0.5623413251903491, 0.4869675251658631, 0.4216965034285822, 0.3651741272548377, 0.31622776601683794, 0.27384196342643613, 0.23713737056616552, 0.2053525026457146, 0.1778279410038923, 0.1539926526059492, 0.1333521432163324, 0.11547819846894582, 0.1, 0.08659643233600653, 0.07498942093324558, 0.06493816315762113, 0.05623413251903491, 0.04869675251658631, 0.042169650342858224, 0.03651741272548377, 0.03162277660168379, 0.027384196342643614, 0.023713737056616554, 0.02053525026457146, 0.01778279410038923, 0.01539926526059492, 0.01333521432163324, 0.011547819846894581, 0.01, 0.008659643233600654, 0.007498942093324558, 0.006493816315762113, 0.005623413251903491, 0.004869675251658631, 0.004216965034285823, 0.003651741272548377, 0.0031622776601683794, 0.0027384196342643613, 0.0023713737056616554, 0.002053525026457146, 0.0017782794100389228, 0.001539926526059492, 0.001333521432163324, 0.0011547819846894581, 0.001, 0.0008659643233600654, 0.0007498942093324559, 0.0006493816315762113, 0.0005623413251903491, 0.0004869675251658631, 0.00042169650342858224, 0.0003651741272548377, 0.00031622776601683794, 0.0002738419634264361, 0.00023713737056616554, 0.0002053525026457146, 0.00017782794100389227, 0.0001539926526059492, 0.0001333521432163324, 0.00011547819846894582};

__device__ __forceinline__ unsigned pk2(float lo, float hi) { unsigned r; asm("v_cvt_pk_bf16_f32 %0, %1, %2" : "=v"(r) : "v"(lo), "v"(hi)); return r; }
__device__ __forceinline__ float bf_lo(unsigned u) { return __uint_as_float(u << 16); }
__device__ __forceinline__ float bf_hi(unsigned u) { return __uint_as_float(u & 0xffff0000u); }
__device__ __forceinline__ float fexp2(float x) { return __builtin_amdgcn_exp2f(x); }
__device__ __forceinline__ float frcp(float x) { return __builtin_amdgcn_rcpf(x); }
__device__ __forceinline__ float silu_f(float x) { return x * frcp(1.f + fexp2(-1.4426950408889634f * x)); }
__device__ __forceinline__ float gelu_f(float x) { const float u = 0.7978845608028654f * (x + 0.044715f * x * x * x); return x * frcp(1.f + fexp2(-2.885390081777927f * u)); }
__device__ __forceinline__ float gelu_silu_f(float u, float z) { const float t = 0.7978845608028654f * (u + 0.044715f * u * u * u); return u * z * frcp((1.f + fexp2(-2.885390081777927f * t)) * (1.f + fexp2(-1.4426950408889634f * z))); }
__device__ __forceinline__ size_t hm(size_t row, int g) { return ((row >> 12) * 8 + g) * SEQ + (row & (SEQ - 1)); }
__device__ __forceinline__ float wave_sum(float v) {
#pragma unroll
    for (int o = 1; o < 64; o <<= 1) v += __shfl_xor(v, o);
    return v;
}
__device__ __forceinline__ void lds_wait() { asm volatile("s_waitcnt lgkmcnt(0)" ::: "memory"); }
__device__ __forceinline__ unsigned off_b(unsigned row, unsigned ch) { return 256u * row + 16u * (ch ^ (((row & 3) << 2) | ((row >> 2) & 3))); }
__device__ __forceinline__ u16x4 tr_read(unsigned lds_addr) { u16x4 r; asm volatile("ds_read_b64_tr_b16 %0, %1\n\ts_waitcnt lgkmcnt(0)" : "=&v"(r) : "v"(lds_addr) : "memory"); return r; }
__device__ __forceinline__ bf16x8 cat4(u16x4 a, u16x4 b) { bf16x8 r; r[0] = a[0]; r[1] = a[1]; r[2] = a[2]; r[3] = a[3]; r[4] = b[0]; r[5] = b[1]; r[6] = b[2]; r[7] = b[3]; return r; }

using pg8::Unit;
__device__ __forceinline__ void st8(bf16_t* p, const float (&v)[8]) { u32x4 w; w.x = pk2(v[0], v[1]); w.y = pk2(v[2], v[3]); w.z = pk2(v[4], v[5]); w.w = pk2(v[6], v[7]); *(u32x4*)p = w; }

struct EpiAB1 {
    static constexpr bool PERM = true, AFTER_DRAIN = false;
    bf16_t *q, *k, *v, *sza, *pp, *gz; const float *cosT, *sinT;
    __device__ __forceinline__ void operator()(const f32x4 (&acc)[2][2][4][2], const Unit& u, int wr, int wc, int fr, int fq) const {
        const int row0 = u.pm * 256 + wr * 64 + fr, pn = u.pn;
        if (pn < 8) {
            bf16_t* dst = pn < 4 ? q : k; const float sc = pn < 4 ? QSCALE : 1.f;
            const int head = (pn & 3) * 2 + (wc >> 1), i0 = 32 * (wc & 1) + 8 * fq;
#pragma unroll
            for (int ai = 0; ai < 2; ++ai)
#pragma unroll
                for (int m = 0; m < 4; ++m) {
                    const int row = row0 + ai * 128 + m * 16, pos = row & (SEQ - 1);
                    const f32x4* cp = (const f32x4*)(cosT + pos * 64 + i0); const f32x4* sp = (const f32x4*)(sinT + pos * 64 + i0);
                    const f32x4 c0 = cp[0], c1 = cp[1], s0 = sp[0], s1 = sp[1];
                    float o1[8], o2[8];
#pragma unroll
                    for (int j = 0; j < 4; ++j) {
                        const float a0 = acc[ai][0][m][0][j], b0 = acc[ai][1][m][0][j], a1 = acc[ai][0][m][1][j], b1 = acc[ai][1][m][1][j];
                        o1[j] = (a0 * c0[j] - b0 * s0[j]) * sc; o2[j] = (b0 * c0[j] + a0 * s0[j]) * sc;
                        o1[4 + j] = (a1 * c1[j] - b1 * s1[j]) * sc; o2[4 + j] = (b1 * c1[j] + a1 * s1[j]) * sc;
                    }
                    bf16_t* rp = dst + hm(row, head) * 128 + i0;
                    st8(rp, o1); st8(rp + 64, o2);
                }
        } else if (pn < 16) {
            const bool isv = pn < 12; bf16_t* dst = isv ? v : sza; const int dim = wc * 32 + 8 * fq;
#pragma unroll
            for (int ai = 0; ai < 2; ++ai)
#pragma unroll
                for (int m = 0; m < 4; ++m) {
                    const size_t row = row0 + ai * 128 + m * 16;
#pragma unroll
                    for (int bj = 0; bj < 2; ++bj) { float o[8];
#pragma unroll
                        for (int j = 0; j < 4; ++j) { const float a = acc[ai][bj][m][0][j], b = acc[ai][bj][m][1][j]; o[j] = isv ? a : silu_f(a); o[4 + j] = isv ? b : silu_f(b); }
                        st8(dst + hm(row, (pn & 3) * 2 + bj) * 128 + dim, o); }
                }
        } else {
            const bool isp = wc < 2; bf16_t* dst = isp ? pp : gz; const int grp = (pn - 16) >> 1, dim = ((pn - 16) & 1) * 64 + (wc & 1) * 32 + 8 * fq;
#pragma unroll
            for (int ai = 0; ai < 2; ++ai)
#pragma unroll
                for (int m = 0; m < 4; ++m) { float o[8];
#pragma unroll
                    for (int j = 0; j < 4; ++j) { const float a0 = acc[ai][0][m][0][j], b0 = acc[ai][1][m][0][j], a1 = acc[ai][0][m][1][j], b1 = acc[ai][1][m][1][j];
                        o[j] = isp ? a0 * b0 : a0 * silu_f(b0); o[4 + j] = isp ? a1 * b1 : a1 * silu_f(b1); }
                    st8(dst + hm(row0 + ai * 128 + m * 16, grp) * 128 + dim, o); }
        }
    }
};
struct EpiSG1 {
    static constexpr bool PERM = true, AFTER_DRAIN = false;
    bf16_t *uz, *gv; float* stats;
    __device__ __forceinline__ void operator()(const f32x4 (&acc)[2][2][4][2], const Unit& u, int wr, int wc, int fr, int fq) const {
        const int row0 = u.pm * 256 + wr * 64 + fr, pn = u.pn;
        if (pn < 16) {
            const int colt = pn * 128 + wc * 32 + 8 * fq;
#pragma unroll
            for (int ai = 0; ai < 2; ++ai)
#pragma unroll
                for (int m = 0; m < 4; ++m) { float o[8];
#pragma unroll
                    for (int j = 0; j < 4; ++j) { o[j] = gelu_silu_f(acc[ai][0][m][0][j], acc[ai][1][m][0][j]); o[4 + j] = gelu_silu_f(acc[ai][0][m][1][j], acc[ai][1][m][1][j]); }
                    st8(uz + (size_t)(row0 + ai * 128 + m * 16) * DM + colt, o); }
        } else {
            const int colt = (pn - 16) * 256 + wc * 32 + 8 * fq;
#pragma unroll
            for (int ai = 0; ai < 2; ++ai)
#pragma unroll
                for (int m = 0; m < 4; ++m) { const int row = row0 + ai * 128 + m * 16; float s1 = 0.f, s2 = 0.f;
#pragma unroll
                    for (int bj = 0; bj < 2; ++bj) { float o[8];
#pragma unroll
                        for (int j = 0; j < 4; ++j) { o[j] = gelu_f(acc[ai][bj][m][0][j]); o[4 + j] = gelu_f(acc[ai][bj][m][1][j]); }
#pragma unroll
                        for (int j = 0; j < 8; ++j) { s1 += o[j]; s2 += o[j] * o[j]; }
                        st8(gv + (size_t)row * DM + colt + bj * 128, o); }
                    s1 += __shfl_xor(s1, 16); s2 += __shfl_xor(s2, 16); s1 += __shfl_xor(s1, 32); s2 += __shfl_xor(s2, 32);
                    if (fq == 0) { float2 w; w.x = s1; w.y = s2; *(float2*)(stats + ((size_t)row * 32 + (pn - 16) * 4 + wc) * 2) = w; }
                }
        }
    }
};
struct EpiDelta {
    static constexpr bool PERM = true, AFTER_DRAIN = false;
    bf16_t* dl; const float* gate;
    __device__ __forceinline__ void operator()(const f32x4 (&acc)[2][2][4][2], const Unit& u, int wr, int wc, int fr, int fq) const {
        if (!dl) return;
        const int row0 = u.pm * 256 + wr * 64 + fr, col0 = u.pn * 256 + wc * 32 + 8 * fq;
        const float* gp = gate + (size_t)(u.pm >> 4) * 6144 + col0;
        f32x4 g[2][2];
#pragma unroll
        for (int bj = 0; bj < 2; ++bj)
#pragma unroll
            for (int n = 0; n < 2; ++n) g[bj][n] = *(const f32x4*)(gp + bj * 128 + n * 4);
#pragma unroll
        for (int ai = 0; ai < 2; ++ai)
#pragma unroll
            for (int m = 0; m < 4; ++m) { bf16_t* rp = dl + (size_t)(row0 + ai * 128 + m * 16) * DM + col0;
#pragma unroll
                for (int bj = 0; bj < 2; ++bj) { float o[8];
#pragma unroll
                    for (int j = 0; j < 4; ++j) { o[j] = g[bj][0][j] * acc[ai][bj][m][0][j]; o[4 + j] = g[bj][1][j] * acc[ai][bj][m][1][j]; }
                    st8(rp + bj * 128, o); } }
    }
};

__device__ __forceinline__ int src_col_ab_in(int n) { const int tile = n >> 8, rho = n & 255;
    if (tile < 8) { const int bj = rho >> 7, w = rho & 127; return tile * 256 + (w >> 6) * 128 + bj * 64 + (w & 63); }
    if (tile < 16) return n;
    return 4096 + (rho >> 6) * 1024 + 64 * (tile - 16) + (rho & 63); }
__device__ __forceinline__ int src_col_sg_in(int n) { const int tile = n >> 8, rho = n & 255;
    if (tile < 16) return rho < 128 ? 128 * tile + rho : 4096 + 128 * tile + (rho - 128);
    return 2048 + (tile - 16) * 256 + rho; }
__device__ __forceinline__ void p0_transpose_item(const float* W, int N, bf16_t* WT, int k0, int n0, int nsrc0, LAS float* scr, int lane) {
    float t[32];
    const float* wp = W + (size_t)(k0 + (lane >> 5)) * N + nsrc0 + (lane & 31);
#pragma unroll
    for (int i = 0; i < 32; ++i) t[i] = wp[(size_t)(2 * i) * N];
#pragma unroll
    for (int i = 0; i < 32; ++i) scr[(2 * i + (lane >> 5)) * 33 + (lane & 31)] = t[i];
    lds_wait();
    const int c = lane & 7;
#pragma unroll
    for (int j = 0; j < 4; ++j) { const int n = (lane >> 3) + 8 * j; const LAS float* s = scr + (8 * c) * 33 + n;
        u32x4 o; o.x = pk2(s[0 * 33], s[1 * 33]); o.y = pk2(s[2 * 33], s[3 * 33]); o.z = pk2(s[4 * 33], s[5 * 33]); o.w = pk2(s[6 * 33], s[7 * 33]);
        *(u32x4*)(WT + (size_t)(n0 + n) * DM + k0 + 8 * c) = o; }
    lds_wait();
}
__device__ __forceinline__ void phase_prologue(const Params& P, LAS unsigned char* lds) {
    int tid_ = threadIdx.x; asm volatile("" : "+v"(tid_));
    const int tid = tid_, lane = tid & 63, wave = __builtin_amdgcn_readfirstlane(tid >> 6);
    const int gw = blockIdx.x * NWAVES + wave, NGW = gridDim.x * NWAVES;
    LAS float* scr = (LAS float*)(lds + wave * 8704);
    unsigned char* ws = P.ws; asm volatile("" : "+s"(ws));
    constexpr int IT_AB_IN = N_AB, IT_OUT = DM, IT_SG_IN = N_SG;
    constexpr int IT_TOTAL = 2 * (IT_AB_IN + IT_OUT + IT_SG_IN + IT_OUT);
#ifndef PROBE_PRO
#define PROBE_PRO 1
#endif
    for (int rep_ = 0; rep_ < PROBE_PRO; ++rep_)
    for (int it = gw; it < IT_TOTAL; it += NGW) {
        int r = it; const float* W; bf16_t* WT; int N, kind;
        if (r < 2 * IT_AB_IN) { const int i = r / IT_AB_IN; r -= i * IT_AB_IN; N = N_AB; kind = 0; W = inp(P, I_AB_WIN) + (size_t)i * DM * N_AB; WT = (bf16_t*)(ws + WS_WAB_IN + i * SZ_WAB_IN); }
        else if ((r -= 2 * IT_AB_IN) < 2 * IT_OUT) { const int i = r / IT_OUT; r -= i * IT_OUT; N = DM; kind = 2; W = inp(P, I_AB_WOUT) + (size_t)i * DM * DM; WT = (bf16_t*)(ws + WS_WAB_OUT + i * SZ_WOUT); }
        else if ((r -= 2 * IT_OUT) < 2 * IT_SG_IN) { const int i = r / IT_SG_IN; r -= i * IT_SG_IN; N = N_SG; kind = 1; W = inp(P, I_SG_WIN) + (size_t)i * DM * N_SG; WT = (bf16_t*)(ws + WS_WSG_IN + i * SZ_WSG_IN); }
        else { r -= 2 * IT_SG_IN; const int i = r / IT_OUT; r -= i * IT_OUT; N = DM; kind = 2; W = inp(P, I_SG_WOUT) + (size_t)i * DM * DM; WT = (bf16_t*)(ws + WS_WSG_OUT + i * SZ_WOUT); }
        const int nblk = N / 32, kb = r / nblk, nb = r % nblk, n0 = nb * 32;
        const int ns = kind == 0 ? src_col_ab_in(n0) : (kind == 1 ? src_col_sg_in(n0) : n0);
        p0_transpose_item(W, N, WT, kb * 64, n0, ns, scr, lane);
    }
    float* mod = (float*)(ws + WS_MOD);
    LAS unsigned char* red = lds + 71680;
    for (int it = blockIdx.x; it < 4 * 8 * 24; it += gridDim.x) {
        const int L = it / 192, r = it % 192, kq = r / 24, cgp = r % 24, col = cgp * 256 + 4 * lane, k0 = kq * 256 + wave * 32;
        const float* W = (L & 1) ? inp(P, I_SG_WMOD) + (size_t)(L >> 1) * DM * 6144 : inp(P, I_AB_WMOD) + (size_t)(L >> 1) * DM * 6144;
        const float* bm = (L & 1) ? inp(P, I_SG_BMOD) + (L >> 1) * 6144 : inp(P, I_AB_BMOD) + (L >> 1) * 6144;
        float sc[4];
#pragma unroll
        for (int b = 0; b < 4; ++b) sc[b] = silu_f(inp(P, I_C)[b * DM + k0 + (lane & 31)]);
        f32x4 a[4];
#pragma unroll
        for (int b = 0; b < 4; ++b) a[b] = (f32x4){0.f, 0.f, 0.f, 0.f};
        const float* wp = W + (size_t)k0 * 6144 + col;
#pragma unroll
        for (int kk = 0; kk < 32; ++kk) { const f32x4 w = *(const f32x4*)(wp + (size_t)kk * 6144);
#pragma unroll
            for (int b = 0; b < 4; ++b) a[b] += __shfl(sc[b], kk) * w; }
        if (kq == 0 && wave == 0) { const f32x4 bv = *(const f32x4*)(bm + col);
#pragma unroll
            for (int b = 0; b < 4; ++b) a[b] += bv; }
#pragma unroll
        for (int b = 0; b < 4; ++b) *(LAS f32x4*)(red + ((wave * 4 + b) * 64 + lane) * 16) = a[b];
        __syncthreads();
#pragma unroll
        for (int q = 0; q < 2; ++q) { const int o = tid + 512 * q, b = o >> 8, c = o & 255; float s = 0.f;
#pragma unroll
            for (int w = 0; w < 8; ++w) s += *(const LAS float*)(red + ((w * 4 + b) * 64 + (c >> 2)) * 16 + (c & 3) * 4);
            atomicAdd(mod + ((size_t)L * 4 + b) * 6144 + cgp * 256 + c, s); }
        __syncthreads();
    }
    float* cosT = (float*)(ws + WS_ROPE); float* sinT = cosT + 4096 * 64;
    bf16_t* wsb = (bf16_t*)(ws + WS_WS);
    for (int idx = blockIdx.x * NTHR + tid; idx < 4096 * 64; idx += gridDim.x * NTHR) {
        const int pos = idx >> 6, i = idx & 63;
        const double rev = (double)pos * kInvFreq[i] * 0.15915494309189535;
        const float fr = (float)(rev - floor(rev));
        cosT[idx] = __builtin_amdgcn_cosf(fr); sinT[idx] = __builtin_amdgcn_sinf(fr);
        const float w0 = inp(P, I_SG_WS)[idx];
        wsb[idx] = (bf16_t)(pk2(w0, 0.f) & 0xffffu);
    }
}

__device__ __forceinline__ void phase_norm(const float* xin, const bf16_t* dl, float* xout, const float* g, const float* mod  , bf16_t* h) {
    int tid_ = threadIdx.x; asm volatile("" : "+v"(tid_));
    const int lane = tid_ & 63, wave = __builtin_amdgcn_readfirstlane(tid_ >> 6);
    const int NW = gridDim.x * NWAVES;
    for (int row0 = blockIdx.x * NWAVES + wave; row0 < MTOK; row0 += 2 * NW) {
        f32x4 v[2][8]; u32x2 d[2][8];
#pragma unroll
        for (int q = 0; q < 2; ++q) { const int row = row0 + q * NW; const f32x4* xr = (const f32x4*)(xin + (size_t)row * DM) + lane;
#pragma unroll
            for (int j = 0; j < 8; ++j) v[q][j] = xr[64 * j];
            if (dl) { const u32x2* dr = (const u32x2*)(dl + (size_t)row * DM) + lane;
#pragma unroll
                for (int j = 0; j < 8; ++j) d[q][j] = dr[64 * j]; } }
#pragma unroll
        for (int q = 0; q < 2; ++q) { const int row = row0 + q * NW; float s = 0.f;
            if (dl) {
#pragma unroll
                for (int j = 0; j < 8; ++j) { v[q][j].x += bf_lo(d[q][j].x); v[q][j].y += bf_hi(d[q][j].x); v[q][j].z += bf_lo(d[q][j].y); v[q][j].w += bf_hi(d[q][j].y); } }
            if (xout) { f32x4* xo = (f32x4*)(xout + (size_t)row * DM) + lane;
#pragma unroll
                for (int j = 0; j < 8; ++j) xo[64 * j] = v[q][j]; }
#pragma unroll
            for (int j = 0; j < 8; ++j) s += (v[q][j].x * v[q][j].x + v[q][j].y * v[q][j].y) + (v[q][j].z * v[q][j].z + v[q][j].w * v[q][j].w);
            const float rstd = 1.f / sqrtf(wave_sum(s) * (1.f / DM) + 1e-6f);
            const float* mb = mod + (size_t)(row >> 12) * 6144;
            u32x2* o8 = (u32x2*)(h + (size_t)row * DM) + lane;
#pragma unroll
            for (int j = 0; j < 8; ++j) { const int c = 4 * lane + 256 * j;
                const f32x4 gg = *(const f32x4*)(g + c), sh = *(const f32x4*)(mb + c), sc = *(const f32x4*)(mb + 2048 + c);
                const f32x4 y = v[q][j] * rstd * gg * (1.f + sc) + sh;
                u32x2 w; w.x = pk2(y.x, y.y); w.y = pk2(y.z, y.w); o8[64 * j] = w; } }
    }
}
__device__ __forceinline__ void phase_final(const float* xin, const bf16_t* dl, const float* g, float* out) {
    int tid_ = threadIdx.x; asm volatile("" : "+v"(tid_));
    const int lane = tid_ & 63, wave = __builtin_amdgcn_readfirstlane(tid_ >> 6);
    const int NW = gridDim.x * NWAVES;
    for (int row0 = blockIdx.x * NWAVES + wave; row0 < MTOK; row0 += 2 * NW) {
        f32x4 v[2][8]; u32x2 d[2][8];
#pragma unroll
        for (int q = 0; q < 2; ++q) { const int row = row0 + q * NW; const f32x4* xr = (const f32x4*)(xin + (size_t)row * DM) + lane; const u32x2* dr = (const u32x2*)(dl + (size_t)row * DM) + lane;
#pragma unroll
            for (int j = 0; j < 8; ++j) { v[q][j] = xr[64 * j]; d[q][j] = dr[64 * j]; } }
#pragma unroll
        for (int q = 0; q < 2; ++q) { const int row = row0 + q * NW; float s = 0.f;
#pragma unroll
            for (int j = 0; j < 8; ++j) { v[q][j].x += bf_lo(d[q][j].x); v[q][j].y += bf_hi(d[q][j].x); v[q][j].z += bf_lo(d[q][j].y); v[q][j].w += bf_hi(d[q][j].y);
                s += (v[q][j].x * v[q][j].x + v[q][j].y * v[q][j].y) + (v[q][j].z * v[q][j].z + v[q][j].w * v[q][j].w); }
            const float rstd = 1.f / sqrtf(wave_sum(s) * (1.f / DM) + 1e-6f);
            f32x4* o = (f32x4*)(out + (size_t)row * DM) + lane;
#pragma unroll
            for (int j = 0; j < 8; ++j) o[64 * j] = v[q][j] * rstd * *(const f32x4*)(g + 4 * lane + 256 * j); }
    }
}

#define MFMA32(a, b, c) __builtin_amdgcn_mfma_f32_32x32x16_bf16((a), (b), (c), 0, 0, 0)
__device__ __forceinline__ void phase_attn_items(const Params& P, LAS unsigned char* lds) {
    unsigned char* ws = P.ws; asm volatile("" : "+s"(ws));
    int tid_ = threadIdx.x; asm volatile("" : "+v"(tid_));
    const int tid = tid_, wave = __builtin_amdgcn_readfirstlane(tid >> 6);
    const bf16_t* Q = (const bf16_t*)(ws + WS_Q); const bf16_t* Kb = (const bf16_t*)(ws + WS_K); const bf16_t* Vb = (const bf16_t*)(ws + WS_V);
    bf16_t* OpB = (bf16_t*)(ws + WS_OP); float* LseB = (float*)(ws + WS_LSE);
    const bool xmap = gridDim.x == 256;
    for (int it = 0; it < (xmap ? 6 : (3 * 512 + (int)gridDim.x - 1) / (int)gridDim.x); ++it) {
        int lane = tid & 63; asm volatile("" : "+v"(lane));
        int pat, b, hh, rc;
        if (xmap) { const int g = it * 32 + (blockIdx.x >> 3), pair = 4 * (blockIdx.x & 7) + g / 48, within = g % 48; pat = within >> 4; rc = within & 15; b = pair >> 3; hh = pair & 7; }
        else { const int item = it * gridDim.x + blockIdx.x; if (item >= 3 * 512) break; pat = item >> 9; const int rem = item & 511; b = rem >> 7; hh = (rem >> 4) & 7; rc = rem & 15; }
        const int dlog = 2 * pat, r = pat == 0 ? 0 : (pat == 1 ? rc >> 2 : rc), ch8 = pat == 0 ? rc : (pat == 1 ? rc & 3 : 0);
        const int ntile = (SEQ >> dlog) >> 5, ql = lane & 31, h = lane >> 5;
        const size_t rowbase = (size_t)b * SEQ;
        const size_t hbase = ((size_t)b * 8 + hh) * SEQ;
#define TILE_BASE(P_, T_) ((const char*)(P_) + (hbase + ((size_t)(32 * (T_)) << dlog) + r) * 256)
        const int trow = (tid >> 4) & 31, tch = tid & 15;
        const unsigned roff = (unsigned)((trow << dlog) * 128 + tch * 8) * 2u;
        const unsigned loff = off_b(trow, tch);
        u32x4 kk[12];
#pragma unroll
        for (int i = 0; i < 12; ++i) { const int T = 8 * ch8 - 2 + i; if (T >= 0 && T < ntile) kk[i] = *(const u32x4*)(TILE_BASE(Kb, T) + roff); else kk[i] = (u32x4){0u, 0u, 0u, 0u}; }
        const int qt = 8 * ch8 + wave;
        const size_t qpos = ((size_t)(32 * qt + ql) << dlog) + r, qrow = rowbase + qpos;
        bf16x8 qf[8];
        { const bf16_t* Qp = Q + (hbase + qpos) * 128 + 8 * h;
#pragma unroll
          for (int ks = 0; ks < 8; ++ks) qf[ks] = *(const bf16x8*)(Qp + 16 * ks); }
#pragma unroll
        for (int i = 0; i < 12; ++i) *(LAS u32x4*)(lds + i * 8192 + loff) = kk[i];
        u32x4 vv[12];
#pragma unroll
        for (int i = 0; i < 12; ++i) { const int T = 8 * ch8 - 2 + i; if (T >= 0 && T < ntile) vv[i] = *(const u32x4*)(TILE_BASE(Vb, T) + roff); else vv[i] = (u32x4){0u, 0u, 0u, 0u}; }
        __syncthreads();
        f32x16 S[5];
#pragma unroll
        for (int kt = 0; kt < 5; ++kt) {
            const int T = qt + kt - 2; const bool tv = (T >= 0) && (T < ntile);
            f32x16 s;
#pragma unroll
            for (int i = 0; i < 16; ++i) s[i] = 0.f;
            if (tv) {
                const LAS unsigned char* kl = lds + (wave + kt) * 8192;
                bf16x8 kf[8];
#pragma unroll
                for (int ks = 0; ks < 8; ++ks) kf[ks] = *(const LAS bf16x8*)(kl + off_b(ql, 2 * ks + h));
#pragma unroll
                for (int ks = 0; ks < 8; ++ks) s = MFMA32(kf[ks], qf[ks], s);
            }
            S[kt] = s;
        }
        float mx = -1e30f;
#pragma unroll
        for (int kt = 0; kt < 5; ++kt) {
            const int T = qt + kt - 2; const bool tv = (T >= 0) && (T < ntile);
#pragma unroll
            for (int i = 0; i < 16; ++i) {
                const int kl_ = (i & 3) + 8 * (i >> 2) + 4 * h;
                const bool valid = tv && (kt == 0 ? (kl_ >= ql) : (kt == 4 ? (kl_ <= ql) : true));
                const float sv = valid ? S[kt][i] : -1e30f; S[kt][i] = sv; mx = fmaxf(mx, sv);
            }
        }
        mx = fmaxf(mx, __shfl_xor(mx, 32));
        float sum = 0.f;
        u32x4 pf[5][2];
#pragma unroll
        for (int kt = 0; kt < 5; ++kt) {
            float p[16];
#pragma unroll
            for (int i = 0; i < 16; ++i) { p[i] = fexp2(S[kt][i] - mx); sum += p[i]; }
#pragma unroll
            for (int s = 0; s < 2; ++s) { pf[kt][s].x = pk2(p[8 * s + 0], p[8 * s + 1]); pf[kt][s].y = pk2(p[8 * s + 2], p[8 * s + 3]); pf[kt][s].z = pk2(p[8 * s + 4], p[8 * s + 5]); pf[kt][s].w = pk2(p[8 * s + 6], p[8 * s + 7]); }
        }
        sum += __shfl_xor(sum, 32);
        __syncthreads();
#pragma unroll
        for (int i = 0; i < 12; ++i) *(LAS u32x4*)(lds + i * 8192 + loff) = vv[i];
        __syncthreads();
        f32x16 O[4];
#pragma unroll
        for (int c = 0; c < 4; ++c)
#pragma unroll
            for (int i = 0; i < 16; ++i) O[c][i] = 0.f;
        const unsigned blk = (lane >> 4) & 1, qq = (lane & 15) >> 2, pq = lane & 3;
        unsigned va[4][2];
#pragma unroll
        for (int c = 0; c < 4; ++c)
#pragma unroll
            for (int t = 0; t < 2; ++t) va[c][t] = (unsigned)(size_t)lds + wave * 8192 + off_b(8 * t + 4 * h + qq, 4 * c + 2 * blk + (pq >> 1)) + 8 * (pq & 1);
#pragma unroll
        for (int kt = 0; kt < 5; ++kt) {
            const int T = qt + kt - 2; const bool tv = (T >= 0) && (T < ntile);
            if (tv) {
                u16x4 t00, t01, t10, t11, t20, t21, t30, t31, u00, u01, u10, u11, u20, u21, u30, u31;
                asm volatile("s_waitcnt lgkmcnt(0)\n\t"
                             "ds_read_b64_tr_b16 %0, %16\n\tds_read_b64_tr_b16 %1, %17\n\tds_read_b64_tr_b16 %2, %18\n\tds_read_b64_tr_b16 %3, %19\n\t"
                             "ds_read_b64_tr_b16 %4, %20\n\tds_read_b64_tr_b16 %5, %21\n\tds_read_b64_tr_b16 %6, %22\n\tds_read_b64_tr_b16 %7, %23\n\t"
                             "ds_read_b64_tr_b16 %8, %16 offset:4096\n\tds_read_b64_tr_b16 %9, %17 offset:4096\n\tds_read_b64_tr_b16 %10, %18 offset:4096\n\tds_read_b64_tr_b16 %11, %19 offset:4096\n\t"
                             "ds_read_b64_tr_b16 %12, %20 offset:4096\n\tds_read_b64_tr_b16 %13, %21 offset:4096\n\tds_read_b64_tr_b16 %14, %22 offset:4096\n\tds_read_b64_tr_b16 %15, %23 offset:4096\n\t"
                             "s_waitcnt lgkmcnt(0)"
                             : "=&v"(t00), "=&v"(t01), "=&v"(t10), "=&v"(t11), "=&v"(t20), "=&v"(t21), "=&v"(t30), "=&v"(t31),
                               "=&v"(u00), "=&v"(u01), "=&v"(u10), "=&v"(u11), "=&v"(u20), "=&v"(u21), "=&v"(u30), "=&v"(u31)
                             : "v"(va[0][0] + kt * 8192), "v"(va[0][1] + kt * 8192), "v"(va[1][0] + kt * 8192), "v"(va[1][1] + kt * 8192),
                               "v"(va[2][0] + kt * 8192), "v"(va[2][1] + kt * 8192), "v"(va[3][0] + kt * 8192), "v"(va[3][1] + kt * 8192) : "memory");
                const bf16x8 p0 = __builtin_bit_cast(bf16x8, pf[kt][0]), p1 = __builtin_bit_cast(bf16x8, pf[kt][1]);
                O[0] = MFMA32(cat4(t00, t01), p0, O[0]); O[1] = MFMA32(cat4(t10, t11), p0, O[1]); O[2] = MFMA32(cat4(t20, t21), p0, O[2]); O[3] = MFMA32(cat4(t30, t31), p0, O[3]);
                O[0] = MFMA32(cat4(u00, u01), p1, O[0]); O[1] = MFMA32(cat4(u10, u11), p1, O[1]); O[2] = MFMA32(cat4(u20, u21), p1, O[2]); O[3] = MFMA32(cat4(u30, u31), p1, O[3]);
            }
        }
        const float inv = 1.f / sum;
        bf16_t* op = OpB + (size_t)pat * MTOK * AW + (hbase + qpos) * 128 + 4 * h;
#pragma unroll
        for (int c = 0; c < 4; ++c)
#pragma unroll
            for (int g = 0; g < 4; ++g) { u32x2 w; w.x = pk2(O[c][4 * g] * inv, O[c][4 * g + 1] * inv); w.y = pk2(O[c][4 * g + 2] * inv, O[c][4 * g + 3] * inv);
                *(u32x2*)(op + 32 * c + 8 * g) = w; }
        if (h == 0) LseB[(size_t)pat * MTOK * 8 + qrow * 8 + hh] = (mx + __builtin_amdgcn_logf(sum)) * LN2F;
        __syncthreads();
#undef TILE_BASE
    }
}

__device__ __forceinline__ void phase_combine(const Params& P, int layer_i) {
    unsigned char* ws = P.ws; asm volatile("" : "+s"(ws));
    int tid_ = threadIdx.x; asm volatile("" : "+v"(tid_));
    const int tid2 = tid_;
    const bf16_t* sza = (const bf16_t*)(ws + WS_SZA); const bf16_t* pp = (const bf16_t*)(ws + WS_PP); const bf16_t* gz = (const bf16_t*)(ws + WS_GZ);
    const bf16_t* Op = (const bf16_t*)(ws + WS_OP); const float* Lse = (const float*)(ws + WS_LSE); bf16_t* Y = (bf16_t*)(ws + WS_H);
    const float* cw = inp(P, I_AB_CONV) + (size_t)layer_i * 3 * AW;
    for (int item = blockIdx.x; item < NB * 8 * 8; item += gridDim.x) {
        const int b = item >> 6, hh = (item >> 3) & 7, seg = item & 7, s0 = seg * 512;
        const int cl = tid2 & 15, col = hh * 128 + cl * 8;
        float w0[8], w1[8], w2[8];
#pragma unroll
        for (int e = 0; e < 8; ++e) { w0[e] = cw[col + e]; w1[e] = cw[AW + col + e]; w2[e] = cw[2 * AW + col + e]; }
#pragma unroll 2
        for (int pass = 0; pass < 16; ++pass) {
            const int pos = s0 + pass * 32 + (tid2 >> 4); const size_t row = (size_t)b * SEQ + pos;
            const float l0 = Lse[row * 8 + hh], l1 = Lse[(size_t)MTOK * 8 + row * 8 + hh], l2 = Lse[(size_t)2 * MTOK * 8 + row * 8 + hh];
            const float lm = fmaxf(l0, fmaxf(l1, l2));
            float e0 = fexp2((l0 - lm) * 1.4426950408889634f), e1 = fexp2((l1 - lm) * 1.4426950408889634f), e2 = fexp2((l2 - lm) * 1.4426950408889634f);
            const float ei = 1.f / (e0 + e1 + e2); e0 *= ei; e1 *= ei; e2 *= ei;
            const size_t hx = hm(row, hh) * 128 + cl * 8;
            const u32x4 a0 = *(const u32x4*)(Op + hx), a1 = *(const u32x4*)(Op + (size_t)MTOK * AW + hx), a2 = *(const u32x4*)(Op + (size_t)2 * MTOK * AW + hx);
            const u32x4 zz = *(const u32x4*)(sza + hx);
            u32x4 ya;
#pragma unroll
            for (int e = 0; e < 4; ++e) {
                const float lo = (e0 * bf_lo(a0[e]) + e1 * bf_lo(a1[e]) + e2 * bf_lo(a2[e])) * bf_lo(zz[e]);
                const float hi = (e0 * bf_hi(a0[e]) + e1 * bf_hi(a1[e]) + e2 * bf_hi(a2[e])) * bf_hi(zz[e]);
                ya[e] = pk2(lo, hi); }
            *(u32x4*)(Y + row * DM + col) = ya;
            const u32x4 pc = *(const u32x4*)(pp + hx);
            u32x4 pm = (u32x4){0u, 0u, 0u, 0u}, pn = (u32x4){0u, 0u, 0u, 0u};
            if (pos > 0) pm = *(const u32x4*)(pp + hx - 128);
            if (pos < SEQ - 1) pn = *(const u32x4*)(pp + hx + 128);
            const u32x4 gg = *(const u32x4*)(gz + hx);
            u32x4 yb;
#pragma unroll
            for (int e = 0; e < 4; ++e) {
                const float lo = bf_lo(gg[e]) * (w0[2 * e] * bf_lo(pm[e]) + w1[2 * e] * bf_lo(pc[e]) + w2[2 * e] * bf_lo(pn[e]));
                const float hi = bf_hi(gg[e]) * (w0[2 * e + 1] * bf_hi(pm[e]) + w1[2 * e + 1] * bf_hi(pc[e]) + w2[2 * e + 1] * bf_hi(pn[e]));
                yb[e] = pk2(lo, hi); }
            *(u32x4*)(Y + row * DM + AW + col) = yb;
        }
    }
}

constexpr int SG_A = 0, SG_B = 32768, SG_MIX_STRIDE = 1040, SG_STATS = 128 * SG_MIX_STRIDE;
__device__ __forceinline__ void phase_sgu(const Params& P, LAS unsigned char* lds, int layer_i) {
    unsigned char* ws = P.ws; asm volatile("" : "+s"(ws));
    int tid_ = threadIdx.x; asm volatile("" : "+v"(tid_));
    const int tid = tid_, lane = tid & 63, wave = __builtin_amdgcn_readfirstlane(tid >> 6);
    const bf16_t* uz = (const bf16_t*)(ws + WS_UZ); const bf16_t* gv = (const bf16_t*)(ws + WS_GV); const float* stats = (const float*)(ws + WS_STATS);
    const bf16_t* wsb = (const bf16_t*)(ws + WS_WS) + (size_t)layer_i * 8 * 128 * 128;
    const float* lng = inp(P, I_SG_LNG) + layer_i * DM; const float* lnb = inp(P, I_SG_LNB) + layer_i * DM; const float* bs = inp(P, I_SG_BS) + layer_i * 8 * 128;
    bf16_t* Y = (bf16_t*)(ws + WS_H);
    LAS float* st = (LAS float*)(lds + SG_STATS);
    const unsigned lbase = (unsigned)(size_t)lds;
    for (int item = blockIdx.x; item < (MTOK / 128) * 8; item += gridDim.x) {
        const int cn = item >> 3, g = item & 7; const size_t row0 = (size_t)cn * 128;
        { const int rr = tid >> 2, part = tid & 3; const float2* sp = (const float2*)stats + (row0 + rr) * 32 + part * 8; float s1 = 0.f, s2 = 0.f;
#pragma unroll
          for (int i = 0; i < 8; ++i) { const float2 v = sp[i]; s1 += v.x; s2 += v.y; }
          s1 += __shfl_xor(s1, 1); s2 += __shfl_xor(s2, 1); s1 += __shfl_xor(s1, 2); s2 += __shfl_xor(s2, 2);
          const float mu = s1 * (1.f / DM), var = fmaxf(s2 * (1.f / DM) - mu * mu, 0.f);
          if (part == 0) { st[2 * rr] = mu; st[2 * rr + 1] = 1.f / sqrtf(var + 1e-6f); } }
#pragma unroll
        for (int i = 0; i < 4; ++i) { const int n = tid + 512 * i, row = n >> 4, ch = n & 15;
            *(LAS u32x4*)(lds + SG_A + off_b(row, ch)) = *(const u32x4*)(wsb + ((size_t)g * 128 + row) * 128 + ch * 8); }
        __syncthreads();
#pragma unroll
        for (int i = 0; i < 8; ++i) { const int n = tid + 512 * i, row = n >> 5, cc = n & 31, c0 = g * 256 + cc * 8;
            const u32x4 v = *(const u32x4*)(gv + (row0 + row) * DM + c0);
            const float mu = st[2 * row], rs = st[2 * row + 1];
            const f32x4 g0 = *(const f32x4*)(lng + c0), g1 = *(const f32x4*)(lng + c0 + 4), b0 = *(const f32x4*)(lnb + c0), b1 = *(const f32x4*)(lnb + c0 + 4);
            u32x4 o;
            o.x = pk2((bf_lo(v.x) - mu) * rs * g0.x + b0.x, (bf_hi(v.x) - mu) * rs * g0.y + b0.y); o.y = pk2((bf_lo(v.y) - mu) * rs * g0.z + b0.z, (bf_hi(v.y) - mu) * rs * g0.w + b0.w);
            o.z = pk2((bf_lo(v.z) - mu) * rs * g1.x + b1.x, (bf_hi(v.z) - mu) * rs * g1.y + b1.y); o.w = pk2((bf_lo(v.w) - mu) * rs * g1.z + b1.z, (bf_hi(v.w) - mu) * rs * g1.w + b1.w);
            *(LAS u32x4*)(lds + SG_B + (cc >> 4) * 32768 + off_b(row, cc & 15)) = o; }
        __syncthreads();
        const unsigned h = lane >> 5, blk = (lane >> 4) & 1, qq = (lane & 15) >> 2, pp = lane & 3;
        const unsigned bimg = lbase + SG_B + (wave >> 2) * 32768; const int ct = wave & 3;
        bf16x8 bf[8];
#pragma unroll
        for (int ks = 0; ks < 8; ++ks) {
            const u16x4 t0 = tr_read(bimg + off_b(16 * ks + 8 * h + qq, 4 * ct + 2 * blk + (pp >> 1)) + 8 * (pp & 1));
            const u16x4 t1 = tr_read(bimg + off_b(16 * ks + 8 * h + 4 + qq, 4 * ct + 2 * blk + (pp >> 1)) + 8 * (pp & 1));
            bf[ks] = cat4(t0, t1); }
        f32x16 acc[4];
#pragma unroll
        for (int tt = 0; tt < 4; ++tt) {
#pragma unroll
            for (int i = 0; i < 16; ++i) acc[tt][i] = 0.f;
#pragma unroll
            for (int ks = 0; ks < 8; ++ks) { const bf16x8 af = *(const LAS bf16x8*)(lds + SG_A + off_b(32 * tt + (lane & 31), 2 * ks + h)); acc[tt] = MFMA32(af, bf[ks], acc[tt]); }
        }
        __syncthreads();
#pragma unroll
        for (int tt = 0; tt < 4; ++tt)
#pragma unroll
            for (int i = 0; i < 16; ++i) { const int t = 32 * tt + (i & 3) + 8 * (i >> 2) + 4 * h;
                *(LAS float*)(lds + t * SG_MIX_STRIDE + (32 * wave + (lane & 31)) * 4) = acc[tt][i] + bs[g * 128 + t]; }
        __syncthreads();
#pragma unroll
        for (int i = 0; i < 8; ++i) { const int n = tid + 512 * i, row = n >> 5, cc = n & 31;
            const f32x4 m0 = *(const LAS f32x4*)(lds + row * SG_MIX_STRIDE + cc * 32), m1 = *(const LAS f32x4*)(lds + row * SG_MIX_STRIDE + cc * 32 + 16);
            const size_t o = (row0 + row) * DM + g * 256 + cc * 8;
            const u32x4 u = *(const u32x4*)(uz + o);
            u32x4 y; y.x = pk2(bf_lo(u.x) * m0.x, bf_hi(u.x) * m0.y); y.y = pk2(bf_lo(u.y) * m0.z, bf_hi(u.y) * m0.w); y.z = pk2(bf_lo(u.z) * m1.x, bf_hi(u.z) * m1.y); y.w = pk2(bf_lo(u.w) * m1.z, bf_hi(u.w) * m1.w);
            *(u32x4*)(Y + o) = y; }
        __syncthreads();
    }
}

#define XB_TMO      128
#define XB_XCNT(j)  (256  + 64 * (j))
#define XB_XSUB(j)  (1280 + 64 * (j))
#define XB_XGEN(j)  (2304 + 64 * (j))
#define XB_TOP      3328
#define XB_TOPGEN   3392
#define XCD_BAR_WORDS 3456
#define XB_SPIN_CAP (1u << 23)

__device__ __forceinline__ unsigned xb_ld(unsigned* p)              { return __hip_atomic_load(p, __ATOMIC_RELAXED, __HIP_MEMORY_SCOPE_AGENT); }
__device__ __forceinline__ unsigned xb_add(unsigned* p, unsigned v) { return __hip_atomic_fetch_add(p, v, __ATOMIC_RELAXED, __HIP_MEMORY_SCOPE_AGENT); }
__device__ __forceinline__ unsigned xb_xcc_id() { return (unsigned)__builtin_amdgcn_s_getreg((3 << 11) | 20) & 0xFu; }
#define XB_SPIN(cond, bar) do { unsigned _sp = 0; while (cond) { __builtin_amdgcn_s_sleep(1); \
    if ((++_sp & 255u) == 0u) { if (xb_ld(&(bar)[XB_TMO])) break; if (_sp > XB_SPIN_CAP) { atomicAdd(&(bar)[XB_TMO], 1u); break; } } } } while (0)

struct XcdBarrier {
    unsigned* bar; unsigned x;
    volatile LAS unsigned* st;
};

__device__ __forceinline__ XcdBarrier xcd_barrier_post(unsigned* bar, volatile LAS unsigned* st) {
    XcdBarrier b; b.bar = bar; b.x = xb_xcc_id(); b.st = st;
    if (threadIdx.x == 0) (void)xb_add(&bar[XB_XCNT(b.x)], 1u);
    return b;
}
__device__ __forceinline__ void xcd_barrier_complete(unsigned* bar, unsigned x, unsigned& nloc, unsigned& nx) {
    const unsigned G = gridDim.x * gridDim.y * gridDim.z;
    unsigned sum, cnt, mine, sp = 0u;
    for (;;) {
        sum = 0u; cnt = 0u; mine = 0u;
#pragma unroll
        for (unsigned j = 0; j < 16; ++j) { const unsigned c = xb_ld(&bar[XB_XCNT(j)]); sum += c; cnt += (c > 0u) ? 1u : 0u; mine = (j == x) ? c : mine; }
        if (sum == G) break;
        __builtin_amdgcn_s_sleep(1);
        if ((++sp & 255u) == 0u) { if (xb_ld(&bar[XB_TMO])) break; if (sp > XB_SPIN_CAP) { atomicAdd(&bar[XB_TMO], 1u); break; } }
    }
    nloc = mine > 0u ? mine : 1u; nx = cnt > 0u ? cnt : 1u;
}

__device__ __forceinline__ void xcd_barrier(const XcdBarrier& b) {
    asm volatile("s_waitcnt vmcnt(0)" ::: "memory");
    __syncthreads();
    if (threadIdx.x == 0) {
        unsigned* bar = b.bar;
        __builtin_amdgcn_s_waitcnt(0);
        unsigned nloc = b.st[0], nx = b.st[1];
        if (nloc == 0u) { xcd_barrier_complete(bar, b.x, nloc, nx); b.st[0] = nloc; b.st[1] = nx; }
        const unsigned old = xb_add(&bar[XB_XSUB(b.x)], 1u);
        const unsigned gen = old / nloc;
        if (old + 1u == (gen + 1u) * nloc) {
            __builtin_amdgcn_fence(__ATOMIC_RELEASE, "agent");
            asm volatile("s_waitcnt vmcnt(0)" ::: "memory");
            const unsigned og = xb_add(&bar[XB_TOP], 1u);
            const unsigned tg = og / nx;
            if (og + 1u == (tg + 1u) * nx) xb_add(&bar[XB_TOPGEN], 1u);
            else XB_SPIN(xb_ld(&bar[XB_TOPGEN]) == tg, bar);
            __builtin_amdgcn_fence(__ATOMIC_ACQUIRE, "agent");
            xb_add(&bar[XB_XGEN(b.x)], 1u);
            asm volatile("s_waitcnt vmcnt(0)" ::: "memory");
        } else {
            XB_SPIN(xb_ld(&bar[XB_XGEN(b.x)]) == gen, bar);
            __builtin_amdgcn_fence(__ATOMIC_ACQUIRE, "agent");
            asm volatile("s_waitcnt vmcnt(0)" ::: "memory");
        }
    }
    __syncthreads();
}


template <class Epi> __device__ __forceinline__ void run_gemm(LAS unsigned char* lds, const bf16_t* A, const bf16_t* Bt, int N, const Epi& E, int pm_mask = -1) {
    pg8::Gemm g; g.A = A; g.Bt = Bt; g.M = MTOK; g.N = N; g.K = DM; g.pm_mask = pm_mask;
    pg8::StaticOrder S; S.init(MTOK, N, (int)gridDim.x, (int)blockIdx.x);
    pg8::gemm_phase<Epi, pg8::StaticOrder, true, true>(lds, g, S, E);
}
__global__ __launch_bounds__(512, 2) void mega_fwd(Params P) {
    extern __shared__ __attribute__((aligned(16))) unsigned char shm[];
    LAS unsigned char* lds = (LAS unsigned char*)shm;
    cg::grid_group grid = cg::this_grid();
    volatile LAS unsigned* xst = (volatile LAS unsigned*)(lds + LDS_XB);
    if (threadIdx.x == 0) { xst[0] = 0u; xst[1] = 0u; }
    __syncthreads();
    XcdBarrier xb = xcd_barrier_post((unsigned*)(P.ws + WS_BAR), xst);
    int nsync = 0;
#ifndef PROBE_REP
#define PROBE_REP 0
#endif
#ifndef PROBE_AI
#define PROBE_AI 1
#endif
#ifndef PROBE_AC
#define PROBE_AC 1
#endif
#ifndef PROBE_SYNCS
#define PROBE_SYNCS 0
#endif
    for (int i = 0; i < PROBE_SYNCS; ++i) xcd_barrier(xb);
    for (int ph2 = 2 * P.ph_lo; ph2 < 2 * P.ph_hi; ++ph2) {
        const int ph = ph2 >> 1;
        if (ph2 & 1) {
            const int sub_ = (ph - 1) & 3, L_ = (ph - 1) >> 2; bool rep = false;
            if (ph >= 1 && ph <= 16) { if (sub_ == 0) rep = (PROBE_REP & 1) && L_ == 0; else if (sub_ == 1) rep = PROBE_REP & 2; else if (sub_ == 2) rep = (L_ & 1) ? (PROBE_REP & 8) : (PROBE_REP & 4); else rep = PROBE_REP & 32; }
            if (!rep) continue;
        }
        if (ph2 > 2 * P.ph_lo) { if (P.ph_hi > 1000) grid.sync(); else xcd_barrier(xb); ++nsync; }
        unsigned char* ws = P.ws; asm volatile("" : "+s"(ws));
        float* xbuf = P.out; asm volatile("" : "+s"(xbuf));
        float* mod = (float*)(ws + WS_MOD);
        bf16_t* H = (bf16_t*)(ws + WS_H);
        if (ph == 0) {
#ifndef SKIP_PRO
            phase_prologue(P, lds);
#endif
            continue; }
        if (ph == 17) { phase_final(xbuf, (const bf16_t*)(ws + WS_DL), inp(P, I_FNG), xbuf); continue; }
        const int L = (ph - 1) >> 2, sub = (ph - 1) & 3, li = L >> 1; const bool sg = L & 1;
        const float* modL = mod + (size_t)L * 4 * 6144;
        if (sub == 0) { phase_norm(L < 2 ? inp(P, I_X) : xbuf, L == 0 ? nullptr : (const bf16_t*)(ws + WS_DL), L == 0 ? nullptr : xbuf, (sg ? inp(P, I_SG_NG) : inp(P, I_AB_NG)) + li * DM, modL, H); }
        else if (sub == 1) {
            if (!sg) { EpiAB1 E; E.q = (bf16_t*)(ws + WS_Q); E.k = (bf16_t*)(ws + WS_K); E.v = (bf16_t*)(ws + WS_V); E.sza = (bf16_t*)(ws + WS_SZA); E.pp = (bf16_t*)(ws + WS_PP); E.gz = (bf16_t*)(ws + WS_GZ);
                E.cosT = (const float*)(ws + WS_ROPE); E.sinT = E.cosT + 4096 * 64;

#ifndef SKIP_G1
                run_gemm(lds, H, (const bf16_t*)(ws + WS_WAB_IN + li * SZ_WAB_IN), N_AB, E);
#endif
            }
            else { EpiSG1 E; E.uz = (bf16_t*)(ws + WS_UZ); E.gv = (bf16_t*)(ws + WS_GV); E.stats = (float*)(ws + WS_STATS);

#ifndef SKIP_G2
                run_gemm(lds, H, (const bf16_t*)(ws + WS_WSG_IN + li * SZ_WSG_IN), N_SG, E);
#endif
            }
        } else if (sub == 2) { if (!sg) {
#ifndef SKIP_ATTN
                for (int rep_ = 0; rep_ < PROBE_AI; ++rep_) phase_attn_items(P, lds);
                xcd_barrier(xb);
                for (int rep_ = 0; rep_ < PROBE_AC; ++rep_) phase_combine(P, li);
#endif
            } else {
#ifndef SKIP_SGU
                phase_sgu(P, lds, li);
#endif
            } }
        else { EpiDelta E; E.dl = (bf16_t*)(ws + WS_DL); E.gate = modL + 4096;
#ifdef PROBE_NOSTORE
            if (ph2 & 1) E.dl = nullptr;
#endif

#ifndef SKIP_G3
#ifdef PROBE_NOSTORE
            run_gemm(lds, H, (const bf16_t*)(ws + (sg ? WS_WSG_OUT : WS_WAB_OUT) + li * SZ_WOUT), DM, E, (ph2 & 1) ? PROBE_PMMASK : -1);
#else
            run_gemm(lds, H, (const bf16_t*)(ws + (sg ? WS_WSG_OUT : WS_WAB_OUT) + li * SZ_WOUT), DM, E);
#endif
#endif
        }
    }
}

#ifndef N_LAUNCH_MODE
#define N_LAUNCH_MODE 1
#endif
extern "C" void kernel_launch(void* const* d_in, const int* in_sizes, int n_in, void* d_out, int out_size, void* d_ws, size_t ws_size, hipStream_t stream) {
    static int grid = 0;
    if (grid == 0) {
        if (n_in != 18 || out_size != MTOK * DM || ws_size < WS_END) { fprintf(stderr, "kernel_launch: unexpected shapes (n_in %d, out %d, ws %zu, need %zu)\n", n_in, out_size, ws_size, (size_t)WS_END); grid = -1; return; }
        int dev = 0, cus = 0, per_cu = 0;
        (void)hipGetDevice(&dev); (void)hipDeviceGetAttribute(&cus, hipDeviceAttributeMultiprocessorCount, dev);
        if (hipFuncSetAttribute((const void*)mega_fwd, hipFuncAttributeMaxDynamicSharedMemorySize, LDS_BYTES) != hipSuccess) { fprintf(stderr, "kernel_launch: hipFuncSetAttribute failed\n"); grid = -1; return; }
        if (hipOccupancyMaxActiveBlocksPerMultiprocessor(&per_cu, (const void*)mega_fwd, NTHR, LDS_BYTES) != hipSuccess || per_cu < 1) { fprintf(stderr, "kernel_launch: occupancy query says %d\n", per_cu); per_cu = 1; }
        (void)hipGetLastError();
        grid = cus * 1;
    }
    if (grid < 0) return;
    (void)hipMemsetAsync((unsigned char*)d_ws + WS_MOD, 0, SZ_MOD + SZ_BAR, stream);
    Params p{};
    for (int i = 0; i < 18; ++i) p.in[i] = (const float*)d_in[i];
    p.out = (float*)d_out; p.ws = (unsigned char*)d_ws;
#if N_LAUNCH_MODE == 1
    p.ph_lo = 0; p.ph_hi = 18;
    void* args[] = {&p};
    hipError_t e = hipLaunchCooperativeKernel((const void*)mega_fwd, dim3(grid), dim3(NTHR), args, LDS_BYTES, stream);
    if (e != hipSuccess) fprintf(stderr, "cooperative launch failed: %s (grid %d)\n", hipGetErrorString(e), grid);
#else
    for (int ph = 0; ph < 18; ++ph) { p.ph_lo = ph; p.ph_hi = ph + 1; hipLaunchKernelGGL(mega_fwd, dim3(grid), dim3(NTHR), LDS_BYTES, stream, p); }
#endif
}
```

```cpp
#include <hip/hip_runtime.h>
#include <hip/hip_cooperative_groups.h>
#include <cstdio>
#include <cstdint>
namespace cg = cooperative_groups;
namespace pg8 {
#define PG8_LAS __attribute__((address_space(3)))
typedef unsigned short bf16_t;
typedef short bf16x8 __attribute__((ext_vector_type(8)));
typedef float f32x4 __attribute__((ext_vector_type(4)));
typedef unsigned u32x4 __attribute__((ext_vector_type(4)));
constexpr int BM = 256, BK = 64, HALF = 128, HTB = HALF * BK * 2  , STAGE_BYTES = 8 * HTB, NXCD = 8, WGM = 8;

__host__ __device__ __forceinline__ int lds_byte(int r, int c) { const int st = (r >> 4) * 2 + (c >> 5), rr = r & 15, cc = c & 31, ob = rr * 64 + cc * 2; return st * 1024 + (ob ^ (((ob >> 9) & 1) << 5)); }
__host__ __device__ __forceinline__ void stage_rc(int b, int& R, int& C) { const int st = b / 1024, sb = b % 1024, swz = sb ^ (((sb >> 9) & 1) << 5); R = (st >> 1) * 16 + swz / 64; C = (st & 1) * 32 + (swz % 64) / 2; }
__host__ __device__ __forceinline__ int perm32(int rho) { const int n = rho >> 4, i = rho & 15; return 8 * (i >> 2) + 4 * n + (i & 3); }

struct Unit { int pm, pn; };
struct Gemm { const bf16_t* A; const bf16_t* Bt; int M, N, K, pm_mask; };

struct StaticOrder {
    int nM, nN, nwg, G, c;
    __host__ __device__ void init(int M, int N, int G_, int c_) { nM = M / BM; nN = N / BM; nwg = nM * nN; G = G_; c = c_; }
    __host__ __device__ bool next(int i, Unit& u) const {
        const long L = (long)i * G + c; if (L >= nwg) return false;
        int wgid = (int)L; { const int q = nwg / NXCD, r = nwg % NXCD, xcd = wgid % NXCD, off = wgid / NXCD; wgid = (xcd < r ? xcd * (q + 1) : r * (q + 1) + (xcd - r) * q) + off; }
        const int nig = WGM * nN, gid = wgid / nig, fm = gid * WGM, gsz = (nM - fm) < WGM ? (nM - fm) : WGM;
        u.pm = fm + ((wgid % nig) % gsz); u.pn = (wgid % nig) / gsz; return true;
    }
    __device__ __forceinline__ void a_ready(const Unit&) const {}
    __device__ __forceinline__ void done(const Unit&) const {}
};

__device__ __forceinline__ unsigned cvt_pk_bf16(float lo, float hi) { unsigned r; asm volatile("v_cvt_pk_bf16_f32 %0, %1, %2" : "=v"(r) : "v"(lo), "v"(hi)); return r; }
template <class Epi, class Sched, bool ALIGN_EPI = false, bool SP2 = false>
__device__ __forceinline__ void gemm_phase(PG8_LAS unsigned char* lds, const Gemm g, const Sched& S, const Epi& E) {
    int tid_ = threadIdx.x; asm volatile("" : "+v"(tid_));
    const int tid = tid_, wid = __builtin_amdgcn_readfirstlane(tid >> 6), lane = tid & 63, wr = wid >> 2, wc = wid & 3, fr = lane & 15, fq = lane >> 4;
    const int K = g.K, nt = K / BK;
    unsigned voffA[2], voffB[2];
#pragma unroll
    for (int i = 0; i < 2; ++i) { int R, C; stage_rc(tid * 16 + i * 8192, R, C); const int Rb = Epi::PERM ? ((R & ~31) + perm32(R & 31)) : R;
        voffA[i] = (unsigned)(R * K + C) * 2u; voffB[i] = (unsigned)(Rb * K + C) * 2u; }
    const size_t kstep = (size_t)(BK * 2);
    const size_t hstep = (size_t)HALF * K * 2;
    const size_t tstep = 2 * hstep;
    const unsigned ldsw = (unsigned)wid * 1024u;
    const int aoff = lds_byte(wr * 64 + fr, fq * 8), boff = lds_byte(wc * 32 + fr, fq * 8);
#define PG8_SA(b, h) (((b) * 2 + (h)) * HTB)
#define PG8_SB(b, h) ((4 + (b) * 2 + (h)) * HTB)
#define PG8_STAGE(bufoff, gbase, voff) do { _Pragma("unroll") for (int _i = 0; _i < 2; ++_i) \
        __builtin_amdgcn_global_load_lds((const unsigned*)((const char*)(gbase) + (voff)[_i]), (PG8_LAS unsigned*)(lds + (bufoff) + ldsw + _i * 8192), 16, 0, 0); } while (0)
#define PG8_LDA(dst, b, h) do { _Pragma("unroll") for (int m = 0; m < 4; ++m) _Pragma("unroll") for (int k = 0; k < 2; ++k) dst[m][k] = *(const PG8_LAS bf16x8*)(lds + PG8_SA(b, h) + aoff + m * 2048 + k * 1024); } while (0)
#define PG8_LDB(dst, b, h) do { _Pragma("unroll") for (int n = 0; n < 2; ++n) _Pragma("unroll") for (int k = 0; k < 2; ++k) dst[n][k] = *(const PG8_LAS bf16x8*)(lds + PG8_SB(b, h) + boff + n * 2048 + k * 1024); } while (0)
#define PG8_MMA(ai, bj, At, Bt) do { __builtin_amdgcn_s_setprio(1); _Pragma("unroll") for (int m = 0; m < 4; ++m) _Pragma("unroll") for (int n = 0; n < 2; ++n) _Pragma("unroll") for (int k = 0; k < 2; ++k) \
        acc[ai][bj][m][n] = __builtin_amdgcn_mfma_f32_16x16x32_bf16(Bt[n][k], At[m][k], acc[ai][bj][m][n], 0, 0, 0); __builtin_amdgcn_s_setprio(0); } while (0)
#define PG8_WAIT_V(n) asm volatile("s_waitcnt vmcnt(" #n ")" ::: "memory")
#define PG8_WAIT_L(n) asm volatile("s_waitcnt lgkmcnt(" #n ")" ::: "memory")
#define PG8_BAR __builtin_amdgcn_s_barrier()
#define PG8_SCHED __builtin_amdgcn_sched_barrier(0)
    Unit cur, nxt; int ui = 0;
    if (!S.next(0, cur)) return;
    f32x4 acc[2][2][4][2];
#pragma unroll
    for (int a = 0; a < 2; ++a)
#pragma unroll
        for (int b = 0; b < 2; ++b)
#pragma unroll
            for (int m = 0; m < 4; ++m)
#pragma unroll
                for (int n = 0; n < 2; ++n) acc[a][b][m][n] = (f32x4){0.f, 0.f, 0.f, 0.f};
    bf16x8 At[4][2], B0[2][2], B1[2][2];
    const char* cA = (const char*)g.A + (size_t)(cur.pm & g.pm_mask) * tstep; const char* cB = (const char*)g.Bt + (size_t)cur.pn * tstep;
    S.a_ready(cur);
    if constexpr (SP2) {
        PG8_STAGE(PG8_SB(0, 0), cB, voffB); PG8_STAGE(PG8_SB(0, 1), cB + hstep, voffB); PG8_STAGE(PG8_SA(0, 0), cA, voffA); PG8_STAGE(PG8_SA(0, 1), cA + hstep, voffA);
        if (wr == 1) PG8_BAR;
        PG8_WAIT_V(2); PG8_BAR;
        PG8_STAGE(PG8_SB(1, 0), cB + kstep, voffB); PG8_STAGE(PG8_SA(1, 0), cA + kstep, voffA); PG8_STAGE(PG8_SB(1, 1), cB + hstep + kstep, voffB);
        PG8_WAIT_V(6); PG8_BAR;
    } else {
        PG8_STAGE(PG8_SB(0, 0), cB, voffB); PG8_STAGE(PG8_SA(0, 0), cA, voffA); PG8_STAGE(PG8_SB(0, 1), cB + hstep, voffB); PG8_STAGE(PG8_SA(0, 1), cA + hstep, voffA);
        if (wr == 1) PG8_BAR;
        PG8_WAIT_V(4); PG8_BAR;
        PG8_STAGE(PG8_SB(1, 0), cB + kstep, voffB); PG8_STAGE(PG8_SA(1, 0), cA + kstep, voffA); PG8_STAGE(PG8_SB(1, 1), cB + hstep + kstep, voffB);
        PG8_WAIT_V(6); PG8_BAR;
    }
    for (;;) {
        const bool has_next = S.next(ui + 1, nxt);
        const char* nA = has_next ? (const char*)g.A + (size_t)(nxt.pm & g.pm_mask) * tstep : cA; const char* nB = has_next ? (const char*)g.Bt + (size_t)nxt.pn * tstep : cB;
        for (int t = 0; t < nt; t += 2) {
            const bool last = (t == nt - 2);
            const char* a1 = cA + (size_t)(t + 1) * kstep;
            const char* a2 = last ? nA : cA + (size_t)(t + 2) * kstep; const char* b2 = last ? nB : cB + (size_t)(t + 2) * kstep;
            const char* a3 = a2 + kstep; const char* b3 = b2 + kstep;
            if (last && has_next) S.a_ready(nxt);
            if constexpr (SP2) {
            PG8_LDB(B0, 0, 0); PG8_LDB(B1, 0, 1); PG8_SCHED; PG8_LDA(At, 0, 0); PG8_STAGE(PG8_SA(1, 1), a1 + hstep, voffA);
            PG8_WAIT_V(8); PG8_WAIT_L(0); PG8_BAR; PG8_MMA(0, 0, At, B0); PG8_MMA(0, 1, At, B1); PG8_BAR; PG8_SCHED;
            PG8_LDA(At, 0, 1); PG8_STAGE(PG8_SB(0, 0), b2, voffB); PG8_STAGE(PG8_SB(0, 1), b2 + hstep, voffB); PG8_STAGE(PG8_SA(0, 0), a2, voffA);
            PG8_WAIT_V(8); PG8_WAIT_L(0); PG8_BAR; PG8_MMA(1, 0, At, B0); PG8_MMA(1, 1, At, B1); PG8_BAR; PG8_SCHED;
            PG8_LDB(B0, 1, 0); PG8_LDB(B1, 1, 1); PG8_SCHED; PG8_LDA(At, 1, 0); PG8_STAGE(PG8_SA(0, 1), a2 + hstep, voffA);
            PG8_WAIT_V(8); PG8_WAIT_L(0); PG8_BAR; PG8_MMA(0, 0, At, B0); PG8_MMA(0, 1, At, B1); PG8_BAR; PG8_SCHED;
            PG8_LDA(At, 1, 1); PG8_STAGE(PG8_SB(1, 0), b3, voffB); PG8_STAGE(PG8_SB(1, 1), b3 + hstep, voffB); PG8_STAGE(PG8_SA(1, 0), a3, voffA);
            PG8_WAIT_V(8); PG8_WAIT_L(0); PG8_BAR; PG8_MMA(1, 0, At, B0); PG8_MMA(1, 1, At, B1); PG8_BAR; PG8_SCHED;
            } else {
            PG8_LDB(B0, 0, 0); PG8_SCHED; PG8_LDA(At, 0, 0); PG8_STAGE(PG8_SA(1, 1), a1 + hstep, voffA);
            PG8_WAIT_L(8); PG8_BAR; PG8_WAIT_L(0); PG8_MMA(0, 0, At, B0); PG8_BAR; PG8_SCHED;
            PG8_LDB(B1, 0, 1); PG8_STAGE(PG8_SB(0, 0), b2, voffB);
            PG8_BAR; PG8_WAIT_L(0); PG8_MMA(0, 1, At, B1); PG8_BAR;
            PG8_LDA(At, 0, 1); PG8_STAGE(PG8_SA(0, 0), a2, voffA);
            PG8_BAR; PG8_WAIT_L(0); PG8_MMA(1, 0, At, B0); PG8_BAR; PG8_SCHED;
            PG8_STAGE(PG8_SB(0, 1), b2 + hstep, voffB);
            PG8_WAIT_V(6); PG8_BAR; PG8_MMA(1, 1, At, B1); PG8_BAR;
            PG8_LDB(B0, 1, 0); PG8_SCHED; PG8_LDA(At, 1, 0); PG8_STAGE(PG8_SA(0, 1), a2 + hstep, voffA);
            PG8_WAIT_L(8); PG8_BAR; PG8_WAIT_L(0); PG8_MMA(0, 0, At, B0); PG8_BAR; PG8_SCHED;
            PG8_LDB(B1, 1, 1); PG8_STAGE(PG8_SB(1, 0), b3, voffB);
            PG8_BAR; PG8_WAIT_L(0); PG8_MMA(0, 1, At, B1); PG8_BAR;
            PG8_LDA(At, 1, 1); PG8_STAGE(PG8_SA(1, 0), a3, voffA);
            PG8_BAR; PG8_WAIT_L(0); PG8_MMA(1, 0, At, B0); PG8_BAR; PG8_SCHED;
            PG8_STAGE(PG8_SB(1, 1), b3 + hstep, voffB);
            PG8_WAIT_V(6); PG8_BAR; PG8_MMA(1, 1, At, B1); PG8_BAR;
            }
        }
        if constexpr (ALIGN_EPI) { if (wr == 0) PG8_BAR; }
        if constexpr (!Epi::AFTER_DRAIN) { E(acc, cur, wr, wc, fr, fq); S.done(cur); }
        if (!has_next) break;
#pragma unroll
        for (int a = 0; a < 2; ++a)
#pragma unroll
            for (int b = 0; b < 2; ++b)
#pragma unroll
                for (int m = 0; m < 4; ++m)
#pragma unroll
                    for (int n = 0; n < 2; ++n) acc[a][b][m][n] = (f32x4){0.f, 0.f, 0.f, 0.f};
        cur = nxt; cA = nA; cB = nB; ++ui;
        if constexpr (ALIGN_EPI) { if (wr == 1) PG8_BAR; }
    }
    PG8_WAIT_V(0);
    if constexpr (!ALIGN_EPI) { if (wr == 0) PG8_BAR; }
    PG8_BAR;
    if constexpr (Epi::AFTER_DRAIN) { E.fused(acc, cur, wr, wc, fr, fq, lds, wid, lane); S.done(cur); }
#undef PG8_SA
#undef PG8_SB
#undef PG8_STAGE
#undef PG8_LDA
#undef PG8_LDB
#undef PG8_MMA
#undef PG8_WAIT_V
#undef PG8_WAIT_L
#undef PG8_BAR
#undef PG8_SCHED
}
}

#define LAS __attribute__((address_space(3)))
typedef unsigned short bf16_t;
typedef short bf16x8 __attribute__((ext_vector_type(8)));
typedef float f32x4 __attribute__((ext_vector_type(4)));
typedef float f32x16 __attribute__((ext_vector_type(16)));
typedef unsigned u32x4 __attribute__((ext_vector_type(4)));
typedef unsigned u32x2 __attribute__((ext_vector_type(2)));
typedef unsigned short u16x4 __attribute__((ext_vector_type(4)));

constexpr int DM = 2048, NB = 4, SEQ = 4096, MTOK = NB * SEQ;
constexpr int AW = 1024;
constexpr int N_AB = 8192, N_SG = 6144;
constexpr int NWAVES = 8, NTHR = 512;
constexpr int LDS_BYTES = 135168;
constexpr int LDS_XB = LDS_BYTES - 16;
constexpr float QSCALE = 0.08838834764831845f * 1.4426950408889634f;
constexpr float LN2F = 0.6931471805599453f;

constexpr size_t SZ_WAB_IN = (size_t)N_AB * DM * 2, SZ_WOUT = (size_t)DM * DM * 2, SZ_WSG_IN = (size_t)N_SG * DM * 2;
constexpr size_t WS_WAB_IN = 0;
constexpr size_t WS_WAB_OUT = WS_WAB_IN + 2 * SZ_WAB_IN;
constexpr size_t WS_WSG_IN = WS_WAB_OUT + 2 * SZ_WOUT;
constexpr size_t WS_WSG_OUT = WS_WSG_IN + 2 * SZ_WSG_IN;
constexpr size_t WS_WS = WS_WSG_OUT + 2 * SZ_WOUT;
constexpr size_t WS_MOD = WS_WS + (size_t)2 * 8 * 128 * 128 * 2;
constexpr size_t SZ_MOD = (size_t)4 * 4 * 6144 * 4;
constexpr size_t WS_BAR = WS_MOD + SZ_MOD;
constexpr size_t SZ_BAR = 16384;
constexpr size_t WS_ROPE = WS_BAR + SZ_BAR;
constexpr size_t WS_STATS = WS_ROPE + (size_t)2 * 4096 * 64 * 4;
constexpr size_t WS_H = WS_STATS + (size_t)MTOK * 32 * 8;
constexpr size_t SZ_ACT = (size_t)MTOK * DM * 2;
constexpr size_t WS_P = WS_H + SZ_ACT;
constexpr size_t SZ_A = (size_t)MTOK * AW * 2;
constexpr size_t WS_Q = WS_P, WS_K = WS_P + SZ_A, WS_V = WS_P + 2 * SZ_A, WS_SZA = WS_P + 3 * SZ_A, WS_PP = WS_P + 4 * SZ_A, WS_GZ = WS_P + 5 * SZ_A;
constexpr size_t WS_OP = WS_P + 6 * SZ_A;
constexpr size_t WS_LSE = WS_OP + 3 * SZ_A;
constexpr size_t WS_END = WS_LSE + (size_t)3 * MTOK * 8 * 4;
constexpr size_t WS_DL = WS_P;
constexpr size_t WS_UZ = WS_P, WS_GV = WS_P + SZ_ACT;

struct Params {
    const float* in[18];
    float* out;
    unsigned char* ws;
    int ph_lo, ph_hi;
};
__device__ __forceinline__ const float* inp(const Params& P, int i) { asm volatile("" : "+s"(i)); return P.in[i]; }
enum { I_X = 0, I_C, I_AB_NG, I_AB_WMOD, I_AB_BMOD, I_AB_WIN, I_AB_CONV, I_AB_WOUT, I_SG_NG, I_SG_WMOD, I_SG_BMOD, I_SG_WIN, I_SG_LNG, I_SG_LNB, I_SG_WS, I_SG_BS, I_SG_WOUT, I_FNG };

__device__ const double kInvFreq[64] = {
1.0, 0.8659643233600653, 0.7498942093324559, 0.6493816315762113, 0.5623413251903491, 0.4869675251658631, 0.4216965034285822, 0.3651741272548377, 0.31622776601683794, 0.27384196342643613, 0.23713737056616552, 0.2053525026457146, 0.1778279410038923, 0.1539926526059492, 0.1333521432163324, 0.11547819846894582, 0.1, 0.08659643233600653, 0.07498942093324558, 0.06493816315762113, 0.05623413251903491, 0.04869675251658631, 0.042169650342858224, 0.03651741272548377, 0.03162277660168379, 0.027384196342643614, 0.023713737056616554, 0.02053525026457146, 0.01778279410038923, 0.01539926526059492, 0.01333521432163324, 0.011547819846894581, 0.01, 0.008659643233600654, 0.007498942093324558, 0.006493816315762113, 0.005623413251903491, 0.004869675251658631, 0.004216965034285823, 0.003651741272548377, 0.0031622776601683794, 0.0027384196342643613, 0.0023713737056616554, 0.002053525026457146, 0.0017782794100389228, 0.001539926526059492, 0.001333521432163324, 0.0011547819846894581, 0.001, 0.0008659643233600654, 0.0007498942093324559, 0.0006493816315762113, 0.0005623413251903491, 0.0004869675251658631, 0.00042169650342858224, 0.0003651741272548377, 0.00031622776601683794, 0.0002738419634264361, 0.00023713737056616554, 0.0002053525026457146, 0.00017782794100389227, 0.0001539926526059492, 0.0001333521432163324, 0.00011547819846894582};

__device__ __forceinline__ unsigned pk2(float lo, float hi) { unsigned r; asm("v_cvt_pk_bf16_f32 %0, %1, %2" : "=v"(r) : "v"(lo), "v"(hi)); return r; }
__device__ __forceinline__ float bf_lo(unsigned u) { return __uint_as_float(u << 16); }
__device__ __forceinline__ float bf_hi(unsigned u) { return __uint_as_float(u & 0xffff0000u); }
__device__ __forceinline__ float fexp2(float x) { return __builtin_amdgcn_exp2f(x); }
__device__ __forceinline__ float frcp(float x) { return __builtin_amdgcn_rcpf(x); }
__device__ __forceinline__ float silu_f(float x) { return x * frcp(1.f + fexp2(-1.4426950408889634f * x)); }
__device__ __forceinline__ float gelu_f(float x) { const float u = 0.7978845608028654f * (x + 0.044715f * x * x * x); return x * frcp(1.f + fexp2(-2.885390081777927f * u)); }
__device__ __forceinline__ float gelu_silu_f(float u, float z) { const float t = 0.7978845608028654f * (u + 0.044715f * u * u * u); return u * z * frcp((1.f + fexp2(-2.885390081777927f * t)) * (1.f + fexp2(-1.4426950408889634f * z))); }
__device__ __forceinline__ float wave_sum(float v) {
#pragma unroll
    for (int o = 1; o < 64; o <<= 1) v += __shfl_xor(v, o);
    return v;
}
__device__ __forceinline__ void lds_wait() { asm volatile("s_waitcnt lgkmcnt(0)" ::: "memory"); }
__device__ __forceinline__ unsigned off_b(unsigned row, unsigned ch) { return 256u * row + 16u * (ch ^ (((row & 3) << 2) | ((row >> 2) & 3))); }
__device__ __forceinline__ u16x4 tr_read(unsigned lds_addr) { u16x4 r; asm volatile("ds_read_b64_tr_b16 %0, %1\n\ts_waitcnt lgkmcnt(0)" : "=&v"(r) : "v"(lds_addr) : "memory"); return r; }
__device__ __forceinline__ bf16x8 cat4(u16x4 a, u16x4 b) { bf16x8 r; r[0] = a[0]; r[1] = a[1]; r[2] = a[2]; r[3] = a[3]; r[4] = b[0]; r[5] = b[1]; r[6] = b[2]; r[7] = b[3]; return r; }

using pg8::Unit;
__device__ __forceinline__ void st8(bf16_t* p, const float (&v)[8]) { u32x4 w; w.x = pk2(v[0], v[1]); w.y = pk2(v[2], v[3]); w.z = pk2(v[4], v[5]); w.w = pk2(v[6], v[7]); *(u32x4*)p = w; }

struct EpiAB1 {
    static constexpr bool PERM = true, AFTER_DRAIN = false;
    bf16_t *q, *k, *v, *sza, *pp, *gz; const float *cosT, *sinT;
    __device__ __forceinline__ void operator()(const f32x4 (&acc)[2][2][4][2], const Unit& u, int wr, int wc, int fr, int fq) const {
        const int row0 = u.pm * 256 + wr * 64 + fr, pn = u.pn;
        if (pn < 8) {
            bf16_t* dst = pn < 4 ? q : k; const float sc = pn < 4 ? QSCALE : 1.f;
            const int head = (pn & 3) * 2 + (wc >> 1), i0 = 32 * (wc & 1) + 8 * fq;
#pragma unroll
            for (int ai = 0; ai < 2; ++ai)
#pragma unroll
                for (int m = 0; m < 4; ++m) {
                    const int row = row0 + ai * 128 + m * 16, pos = row & (SEQ - 1);
                    const f32x4* cp = (const f32x4*)(cosT + pos * 64 + i0); const f32x4* sp = (const f32x4*)(sinT + pos * 64 + i0);
                    const f32x4 c0 = cp[0], c1 = cp[1], s0 = sp[0], s1 = sp[1];
                    float o1[8], o2[8];
#pragma unroll
                    for (int j = 0; j < 4; ++j) {
                        const float a0 = acc[ai][0][m][0][j], b0 = acc[ai][1][m][0][j], a1 = acc[ai][0][m][1][j], b1 = acc[ai][1][m][1][j];
                        o1[j] = (a0 * c0[j] - b0 * s0[j]) * sc; o2[j] = (b0 * c0[j] + a0 * s0[j]) * sc;
                        o1[4 + j] = (a1 * c1[j] - b1 * s1[j]) * sc; o2[4 + j] = (b1 * c1[j] + a1 * s1[j]) * sc;
                    }
                    bf16_t* rp = dst + (size_t)row * AW + head * 128 + i0;
                    st8(rp, o1); st8(rp + 64, o2);
                }
        } else if (pn < 16) {
            const bool isv = pn < 12; bf16_t* dst = isv ? v : sza; const int colt = (pn & 3) * 256 + wc * 32 + 8 * fq;
#pragma unroll
            for (int ai = 0; ai < 2; ++ai)
#pragma unroll
                for (int m = 0; m < 4; ++m) {
                    bf16_t* rp = dst + (size_t)(row0 + ai * 128 + m * 16) * AW + colt;
#pragma unroll
                    for (int bj = 0; bj < 2; ++bj) { float o[8];
#pragma unroll
                        for (int j = 0; j < 4; ++j) { const float a = acc[ai][bj][m][0][j], b = acc[ai][bj][m][1][j]; o[j] = isv ? a : silu_f(a); o[4 + j] = isv ? b : silu_f(b); }
                        st8(rp + bj * 128, o); }
                }
        } else {
            const bool isp = wc < 2; bf16_t* dst = isp ? pp : gz; const int colt = (pn - 16) * 64 + (wc & 1) * 32 + 8 * fq;
#pragma unroll
            for (int ai = 0; ai < 2; ++ai)
#pragma unroll
                for (int m = 0; m < 4; ++m) { float o[8];
#pragma unroll
                    for (int j = 0; j < 4; ++j) { const float a0 = acc[ai][0][m][0][j], b0 = acc[ai][1][m][0][j], a1 = acc[ai][0][m][1][j], b1 = acc[ai][1][m][1][j];
                        o[j] = isp ? a0 * b0 : a0 * silu_f(b0); o[4 + j] = isp ? a1 * b1 : a1 * silu_f(b1); }
                    st8(dst + (size_t)(row0 + ai * 128 + m * 16) * AW + colt, o); }
        }
    }
};
struct EpiSG1 {
    static constexpr bool PERM = true, AFTER_DRAIN = false;
    bf16_t *uz, *gv; float* stats;
    __device__ __forceinline__ void operator()(const f32x4 (&acc)[2][2][4][2], const Unit& u, int wr, int wc, int fr, int fq) const {
        const int row0 = u.pm * 256 + wr * 64 + fr, pn = u.pn;
        if (pn < 16) {
            const int colt = pn * 128 + wc * 32 + 8 * fq;
#pragma unroll
            for (int ai = 0; ai < 2; ++ai)
#pragma unroll
                for (int m = 0; m < 4; ++m) { float o[8];
#pragma unroll
                    for (int j = 0; j < 4; ++j) { o[j] = gelu_silu_f(acc[ai][0][m][0][j], acc[ai][1][m][0][j]); o[4 + j] = gelu_silu_f(acc[ai][0][m][1][j], acc[ai][1][m][1][j]); }
                    st8(uz + (size_t)(row0 + ai * 128 + m * 16) * DM + colt, o); }
        } else {
            const int colt = (pn - 16) * 256 + wc * 32 + 8 * fq;
#pragma unroll
            for (int ai = 0; ai < 2; ++ai)
#pragma unroll
                for (int m = 0; m < 4; ++m) { const int row = row0 + ai * 128 + m * 16; float s1 = 0.f, s2 = 0.f;
#pragma unroll
                    for (int bj = 0; bj < 2; ++bj) { float o[8];
#pragma unroll
                        for (int j = 0; j < 4; ++j) { o[j] = gelu_f(acc[ai][bj][m][0][j]); o[4 + j] = gelu_f(acc[ai][bj][m][1][j]); }
#pragma unroll
                        for (int j = 0; j < 8; ++j) { s1 += o[j]; s2 += o[j] * o[j]; }
                        st8(gv + (size_t)row * DM + colt + bj * 128, o); }
                    s1 += __shfl_xor(s1, 16); s2 += __shfl_xor(s2, 16); s1 += __shfl_xor(s1, 32); s2 += __shfl_xor(s2, 32);
                    if (fq == 0) { float2 w; w.x = s1; w.y = s2; *(float2*)(stats + ((size_t)row * 32 + (pn - 16) * 4 + wc) * 2) = w; }
                }
        }
    }
};
struct EpiDelta {
    static constexpr bool PERM = true, AFTER_DRAIN = false;
    bf16_t* dl; const float* gate;
    __device__ __forceinline__ void operator()(const f32x4 (&acc)[2][2][4][2], const Unit& u, int wr, int wc, int fr, int fq) const {
        if (!dl) return;
        const int row0 = u.pm * 256 + wr * 64 + fr, col0 = u.pn * 256 + wc * 32 + 8 * fq;
        const float* gp = gate + (size_t)(u.pm >> 4) * 6144 + col0;
        f32x4 g[2][2];
#pragma unroll
        for (int bj = 0; bj < 2; ++bj)
#pragma unroll
            for (int n = 0; n < 2; ++n) g[bj][n] = *(const f32x4*)(gp + bj * 128 + n * 4);
#pragma unroll
        for (int ai = 0; ai < 2; ++ai)
#pragma unroll
            for (int m = 0; m < 4; ++m) { bf16_t* rp = dl + (size_t)(row0 + ai * 128 + m * 16) * DM + col0;
#pragma unroll
                for (int bj = 0; bj < 2; ++bj) { float o[8];
#pragma unroll
                    for (int j = 0; j < 4; ++j) { o[j] = g[bj][0][j] * acc[ai][bj][m][0][j]; o[4 + j] = g[bj][1][j] * acc[ai][bj][m][1][j]; }
                    st8(rp + bj * 128, o); } }
    }
};

__device__ __forceinline__ int src_col_ab_in(int n) { const int tile = n >> 8, rho = n & 255;
    if (tile < 8) { const int bj = rho >> 7, w = rho & 127; return tile * 256 + (w >> 6) * 128 + bj * 64 + (w & 63); }
    if (tile < 16) return n;
    return 4096 + (rho >> 6) * 1024 + 64 * (tile - 16) + (rho & 63); }
__device__ __forceinline__ int src_col_sg_in(int n) { const int tile = n >> 8, rho = n & 255;
    if (tile < 16) return rho < 128 ? 128 * tile + rho : 4096 + 128 * tile + (rho - 128);
    return 2048 + (tile - 16) * 256 + rho; }
__device__ __forceinline__ void p0_transpose_item(const float* W, int N, bf16_t* WT, int k0, int n0, int nsrc0, LAS float* scr, int lane) {
    float t[32];
    const float* wp = W + (size_t)(k0 + (lane >> 5)) * N + nsrc0 + (lane & 31);
#pragma unroll
    for (int i = 0; i < 32; ++i) t[i] = wp[(size_t)(2 * i) * N];
#pragma unroll
    for (int i = 0; i < 32; ++i) scr[(2 * i + (lane >> 5)) * 33 + (lane & 31)] = t[i];
    lds_wait();
    const int c = lane & 7;
#pragma unroll
    for (int j = 0; j < 4; ++j) { const int n = (lane >> 3) + 8 * j; const LAS float* s = scr + (8 * c) * 33 + n;
        u32x4 o; o.x = pk2(s[0 * 33], s[1 * 33]); o.y = pk2(s[2 * 33], s[3 * 33]); o.z = pk2(s[4 * 33], s[5 * 33]); o.w = pk2(s[6 * 33], s[7 * 33]);
        *(u32x4*)(WT + (size_t)(n0 + n) * DM + k0 + 8 * c) = o; }
    lds_wait();
}
__device__ __forceinline__ void phase_prologue(const Params& P, LAS unsigned char* lds) {
    int tid_ = threadIdx.x; asm volatile("" : "+v"(tid_));
    const int tid = tid_, lane = tid & 63, wave = __builtin_amdgcn_readfirstlane(tid >> 6);
    const int gw = blockIdx.x * NWAVES + wave, NGW = gridDim.x * NWAVES;
    LAS float* scr = (LAS float*)(lds + wave * 8704);
    unsigned char* ws = P.ws; asm volatile("" : "+s"(ws));
    constexpr int IT_AB_IN = N_AB, IT_OUT = DM, IT_SG_IN = N_SG;
    constexpr int IT_TOTAL = 2 * (IT_AB_IN + IT_OUT + IT_SG_IN + IT_OUT);
#ifndef PROBE_PRO
#define PROBE_PRO 1
#endif
    for (int rep_ = 0; rep_ < PROBE_PRO; ++rep_)
    for (int it = gw; it < IT_TOTAL; it += NGW) {
        int r = it; const float* W; bf16_t* WT; int N, kind;
        if (r < 2 * IT_AB_IN) { const int i = r / IT_AB_IN; r -= i * IT_AB_IN; N = N_AB; kind = 0; W = inp(P, I_AB_WIN) + (size_t)i * DM * N_AB; WT = (bf16_t*)(ws + WS_WAB_IN + i * SZ_WAB_IN); }
        else if ((r -= 2 * IT_AB_IN) < 2 * IT_OUT) { const int i = r / IT_OUT; r -= i * IT_OUT; N = DM; kind = 2; W = inp(P, I_AB_WOUT) + (size_t)i * DM * DM; WT = (bf16_t*)(ws + WS_WAB_OUT + i * SZ_WOUT); }
        else if ((r -= 2 * IT_OUT) < 2 * IT_SG_IN) { const int i = r / IT_SG_IN; r -= i * IT_SG_IN; N = N_SG; kind = 1; W = inp(P, I_SG_WIN) + (size_t)i * DM * N_SG; WT = (bf16_t*)(ws + WS_WSG_IN + i * SZ_WSG_IN); }
        else { r -= 2 * IT_SG_IN; const int i = r / IT_OUT; r -= i * IT_OUT; N = DM; kind = 2; W = inp(P, I_SG_WOUT) + (size_t)i * DM * DM; WT = (bf16_t*)(ws + WS_WSG_OUT + i * SZ_WOUT); }
        const int nblk = N / 32, kb = r / nblk, nb = r % nblk, n0 = nb * 32;
        const int ns = kind == 0 ? src_col_ab_in(n0) : (kind == 1 ? src_col_sg_in(n0) : n0);
        p0_transpose_item(W, N, WT, kb * 64, n0, ns, scr, lane);
    }
    float* mod = (float*)(ws + WS_MOD);
    LAS unsigned char* red = lds + 71680;
    for (int it = blockIdx.x; it < 4 * 8 * 24; it += gridDim.x) {
        const int L = it / 192, r = it % 192, kq = r / 24, cgp = r % 24, col = cgp * 256 + 4 * lane, k0 = kq * 256 + wave * 32;
        const float* W = (L & 1) ? inp(P, I_SG_WMOD) + (size_t)(L >> 1) * DM * 6144 : inp(P, I_AB_WMOD) + (size_t)(L >> 1) * DM * 6144;
        const float* bm = (L & 1) ? inp(P, I_SG_BMOD) + (L >> 1) * 6144 : inp(P, I_AB_BMOD) + (L >> 1) * 6144;
        float sc[4];
#pragma unroll
        for (int b = 0; b < 4; ++b) sc[b] = silu_f(inp(P, I_C)[b * DM + k0 + (lane & 31)]);
        f32x4 a[4];
#pragma unroll
        for (int b = 0; b < 4; ++b) a[b] = (f32x4){0.f, 0.f, 0.f, 0.f};
        const float* wp = W + (size_t)k0 * 6144 + col;
#pragma unroll
        for (int kk = 0; kk < 32; ++kk) { const f32x4 w = *(const f32x4*)(wp + (size_t)kk * 6144);
#pragma unroll
            for (int b = 0; b < 4; ++b) a[b] += __shfl(sc[b], kk) * w; }
        if (kq == 0 && wave == 0) { const f32x4 bv = *(const f32x4*)(bm + col);
#pragma unroll
            for (int b = 0; b < 4; ++b) a[b] += bv; }
#pragma unroll
        for (int b = 0; b < 4; ++b) *(LAS f32x4*)(red + ((wave * 4 + b) * 64 + lane) * 16) = a[b];
        __syncthreads();
#pragma unroll
        for (int q = 0; q < 2; ++q) { const int o = tid + 512 * q, b = o >> 8, c = o & 255; float s = 0.f;
#pragma unroll
            for (int w = 0; w < 8; ++w) s += *(const LAS float*)(red + ((w * 4 + b) * 64 + (c >> 2)) * 16 + (c & 3) * 4);
            atomicAdd(mod + ((size_t)L * 4 + b) * 6144 + cgp * 256 + c, s); }
        __syncthreads();
    }
    float* cosT = (float*)(ws + WS_ROPE); float* sinT = cosT + 4096 * 64;
    bf16_t* wsb = (bf16_t*)(ws + WS_WS);
    for (int idx = blockIdx.x * NTHR + tid; idx < 4096 * 64; idx += gridDim.x * NTHR) {
        const int pos = idx >> 6, i = idx & 63;
        const double rev = (double)pos * kInvFreq[i] * 0.15915494309189535;
        const float fr = (float)(rev - floor(rev));
        cosT[idx] = __builtin_amdgcn_cosf(fr); sinT[idx] = __builtin_amdgcn_sinf(fr);
        const float w0 = inp(P, I_SG_WS)[idx];
        wsb[idx] = (bf16_t)(pk2(w0, 0.f) & 0xffffu);
    }
}

__device__ __forceinline__ void phase_norm(const float* xin, const bf16_t* dl, float* xout, const float* g, const float* mod  , bf16_t* h) {
    int tid_ = threadIdx.x; asm volatile("" : "+v"(tid_));
    const int lane = tid_ & 63, wave = __builtin_amdgcn_readfirstlane(tid_ >> 6);
    const int NW = gridDim.x * NWAVES;
    for (int row0 = blockIdx.x * NWAVES + wave; row0 < MTOK; row0 += 2 * NW) {
        f32x4 v[2][8]; u32x2 d[2][8];
#pragma unroll
        for (int q = 0; q < 2; ++q) { const int row = min(row0 + q * NW, MTOK - 1); const f32x4* xr = (const f32x4*)(xin + (size_t)row * DM) + lane;
#pragma unroll
            for (int j = 0; j < 8; ++j) v[q][j] = xr[64 * j];
            if (dl) { const u32x2* dr = (const u32x2*)(dl + (size_t)row * DM) + lane;
#pragma unroll
                for (int j = 0; j < 8; ++j) d[q][j] = dr[64 * j]; } }
#pragma unroll
        for (int q = 0; q < 2; ++q) { const int row = row0 + q * NW; float s = 0.f;
            if (row >= MTOK) break;
            if (dl) {
#pragma unroll
                for (int j = 0; j < 8; ++j) { v[q][j].x += bf_lo(d[q][j].x); v[q][j].y += bf_hi(d[q][j].x); v[q][j].z += bf_lo(d[q][j].y); v[q][j].w += bf_hi(d[q][j].y); } }
            if (xout) { f32x4* xo = (f32x4*)(xout + (size_t)row * DM) + lane;
#pragma unroll
                for (int j = 0; j < 8; ++j) xo[64 * j] = v[q][j]; }
#pragma unroll
            for (int j = 0; j < 8; ++j) s += (v[q][j].x * v[q][j].x + v[q][j].y * v[q][j].y) + (v[q][j].z * v[q][j].z + v[q][j].w * v[q][j].w);
            const float rstd = 1.f / sqrtf(wave_sum(s) * (1.f / DM) + 1e-6f);
            const float* mb = mod + (size_t)(row >> 12) * 6144;
            u32x2* o8 = (u32x2*)(h + (size_t)row * DM) + lane;
#pragma unroll
            for (int j = 0; j < 8; ++j) { const int c = 4 * lane + 256 * j;
                const f32x4 gg = *(const f32x4*)(g + c), sh = *(const f32x4*)(mb + c), sc = *(const f32x4*)(mb + 2048 + c);
                const f32x4 y = v[q][j] * rstd * gg * (1.f + sc) + sh;
                u32x2 w; w.x = pk2(y.x, y.y); w.y = pk2(y.z, y.w); o8[64 * j] = w; } }
    }
}
__device__ __forceinline__ void phase_final(const float* xin, const bf16_t* dl, const float* g, float* out) {
    int tid_ = threadIdx.x; asm volatile("" : "+v"(tid_));
    const int lane = tid_ & 63, wave = __builtin_amdgcn_readfirstlane(tid_ >> 6);
    const int NW = gridDim.x * NWAVES;
    for (int row0 = blockIdx.x * NWAVES + wave; row0 < MTOK; row0 += 2 * NW) {
        f32x4 v[2][8]; u32x2 d[2][8];
#pragma unroll
        for (int q = 0; q < 2; ++q) { const int row = min(row0 + q * NW, MTOK - 1); const f32x4* xr = (const f32x4*)(xin + (size_t)row * DM) + lane; const u32x2* dr = (const u32x2*)(dl + (size_t)row * DM) + lane;
#pragma unroll
            for (int j = 0; j < 8; ++j) { v[q][j] = xr[64 * j]; d[q][j] = dr[64 * j]; } }
#pragma unroll
        for (int q = 0; q < 2; ++q) { const int row = row0 + q * NW; float s = 0.f;
            if (row >= MTOK) break;
#pragma unroll
            for (int j = 0; j < 8; ++j) { v[q][j].x += bf_lo(d[q][j].x); v[q][j].y += bf_hi(d[q][j].x); v[q][j].z += bf_lo(d[q][j].y); v[q][j].w += bf_hi(d[q][j].y);
                s += (v[q][j].x * v[q][j].x + v[q][j].y * v[q][j].y) + (v[q][j].z * v[q][j].z + v[q][j].w * v[q][j].w); }
            const float rstd = 1.f / sqrtf(wave_sum(s) * (1.f / DM) + 1e-6f);
            f32x4* o = (f32x4*)(out + (size_t)row * DM) + lane;
#pragma unroll
            for (int j = 0; j < 8; ++j) o[64 * j] = v[q][j] * rstd * *(const f32x4*)(g + 4 * lane + 256 * j); }
    }
}

#define MFMA32(a, b, c) __builtin_amdgcn_mfma_f32_32x32x16_bf16((a), (b), (c), 0, 0, 0)
__device__ __forceinline__ void phase_attn_items(const Params& P, LAS unsigned char* lds) {
    unsigned char* ws = P.ws; asm volatile("" : "+s"(ws));
    int tid_ = threadIdx.x; asm volatile("" : "+v"(tid_));
    const int tid = tid_, wave = __builtin_amdgcn_readfirstlane(tid >> 6);
    const bf16_t* Q = (const bf16_t*)(ws + WS_Q); const bf16_t* Kb = (const bf16_t*)(ws + WS_K); const bf16_t* Vb = (const bf16_t*)(ws + WS_V);
    bf16_t* OpB = (bf16_t*)(ws + WS_OP); float* LseB = (float*)(ws + WS_LSE);
    const bool xmap = gridDim.x == 256;
    for (int it = 0; it < (xmap ? 6 : (3 * 512 + (int)gridDim.x - 1) / (int)gridDim.x); ++it) {
        int lane = tid & 63; asm volatile("" : "+v"(lane));
        int pat, b, hh, rc;
        if (xmap) { const int g = it * 32 + (blockIdx.x >> 3), pair = 4 * (blockIdx.x & 7) + g / 48, within = g % 48; pat = within >> 4; rc = within & 15; b = pair >> 3; hh = pair & 7; }
        else { const int item = it * gridDim.x + blockIdx.x; if (item >= 3 * 512) break; pat = item >> 9; const int rem = item & 511; b = rem >> 7; hh = (rem >> 4) & 7; rc = rem & 15; }
        const int dlog = 2 * pat, r = pat == 0 ? 0 : (pat == 1 ? rc >> 2 : rc), ch8 = pat == 0 ? rc : (pat == 1 ? rc & 3 : 0);
        const int ntile = (SEQ >> dlog) >> 5, ql = lane & 31, h = lane >> 5;
        const size_t rowbase = (size_t)b * SEQ;
        const size_t hb = (size_t)hh * 256;
#define TILE_BASE(P_, T_) ((const char*)(P_) + (rowbase + ((size_t)(32 * (T_)) << dlog) + r) * (AW * 2) + hb)
        const int trow = (tid >> 4) & 31, tch = tid & 15;
        const unsigned roff = (unsigned)((trow << dlog) * AW + tch * 8) * 2u;
        const unsigned loff = off_b(trow, tch);
        u32x4 kk[12];
#pragma unroll
        for (int i = 0; i < 12; ++i) { const int T = 8 * ch8 - 2 + i; if (T >= 0 && T < ntile) kk[i] = *(const u32x4*)(TILE_BASE(Kb, T) + roff); else kk[i] = (u32x4){0u, 0u, 0u, 0u}; }
        const int qt = 8 * ch8 + wave;
        const size_t qrow = rowbase + ((size_t)(32 * qt + ql) << dlog) + r;
        bf16x8 qf[8];
        { const bf16_t* Qp = Q + qrow * AW + hh * 128 + 8 * h;
#pragma unroll
          for (int ks = 0; ks < 8; ++ks) qf[ks] = *(const bf16x8*)(Qp + 16 * ks); }
#pragma unroll
        for (int i = 0; i < 12; ++i) *(LAS u32x4*)(lds + i * 8192 + loff) = kk[i];
        u32x4 vv[12];
#pragma unroll
        for (int i = 0; i < 12; ++i) { const int T = 8 * ch8 - 2 + i; if (T >= 0 && T < ntile) vv[i] = *(const u32x4*)(TILE_BASE(Vb, T) + roff); else vv[i] = (u32x4){0u, 0u, 0u, 0u}; }
        __syncthreads();
        f32x16 S[5];
#pragma unroll
        for (int kt = 0; kt < 5; ++kt) {
            const int T = qt + kt - 2; const bool tv = (T >= 0) && (T < ntile);
            f32x16 s;
#pragma unroll
            for (int i = 0; i < 16; ++i) s[i] = 0.f;
            if (tv) {
                const LAS unsigned char* kl = lds + (wave + kt) * 8192;
                bf16x8 kf[8];
#pragma unroll
                for (int ks = 0; ks < 8; ++ks) kf[ks] = *(const LAS bf16x8*)(kl + off_b(ql, 2 * ks + h));
#pragma unroll
                for (int ks = 0; ks < 8; ++ks) s = MFMA32(kf[ks], qf[ks], s);
            }
            S[kt] = s;
        }
        float mx = -1e30f;
#pragma unroll
        for (int kt = 0; kt < 5; ++kt) {
            const int T = qt + kt - 2; const bool tv = (T >= 0) && (T < ntile);
#pragma unroll
            for (int i = 0; i < 16; ++i) {
                const int kl_ = (i & 3) + 8 * (i >> 2) + 4 * h;
                const bool valid = tv && (kt == 0 ? (kl_ >= ql) : (kt == 4 ? (kl_ <= ql) : true));
                const float sv = valid ? S[kt][i] : -1e30f; S[kt][i] = sv; mx = fmaxf(mx, sv);
            }
        }
        mx = fmaxf(mx, __shfl_xor(mx, 32));
        float sum = 0.f;
        u32x4 pf[5][2];
#pragma unroll
        for (int kt = 0; kt < 5; ++kt) {
            float p[16];
#pragma unroll
            for (int i = 0; i < 16; ++i) { p[i] = fexp2(S[kt][i] - mx); sum += p[i]; }
#pragma unroll
            for (int s = 0; s < 2; ++s) { pf[kt][s].x = pk2(p[8 * s + 0], p[8 * s + 1]); pf[kt][s].y = pk2(p[8 * s + 2], p[8 * s + 3]); pf[kt][s].z = pk2(p[8 * s + 4], p[8 * s + 5]); pf[kt][s].w = pk2(p[8 * s + 6], p[8 * s + 7]); }
        }
        sum += __shfl_xor(sum, 32);
        __syncthreads();
#pragma unroll
        for (int i = 0; i < 12; ++i) *(LAS u32x4*)(lds + i * 8192 + loff) = vv[i];
        __syncthreads();
        f32x16 O[4];
#pragma unroll
        for (int c = 0; c < 4; ++c)
#pragma unroll
            for (int i = 0; i < 16; ++i) O[c][i] = 0.f;
        const unsigned blk = (lane >> 4) & 1, qq = (lane & 15) >> 2, pq = lane & 3;
        unsigned va[4][2];
#pragma unroll
        for (int c = 0; c < 4; ++c)
#pragma unroll
            for (int t = 0; t < 2; ++t) va[c][t] = (unsigned)(size_t)lds + wave * 8192 + off_b(8 * t + 4 * h + qq, 4 * c + 2 * blk + (pq >> 1)) + 8 * (pq & 1);
#pragma unroll
        for (int kt = 0; kt < 5; ++kt) {
            const int T = qt + kt - 2; const bool tv = (T >= 0) && (T < ntile);
            if (tv) {
                u16x4 t00, t01, t10, t11, t20, t21, t30, t31, u00, u01, u10, u11, u20, u21, u30, u31;
                asm volatile("s_waitcnt lgkmcnt(0)\n\t"
                             "ds_read_b64_tr_b16 %0, %16\n\tds_read_b64_tr_b16 %1, %17\n\tds_read_b64_tr_b16 %2, %18\n\tds_read_b64_tr_b16 %3, %19\n\t"
                             "ds_read_b64_tr_b16 %4, %20\n\tds_read_b64_tr_b16 %5, %21\n\tds_read_b64_tr_b16 %6, %22\n\tds_read_b64_tr_b16 %7, %23\n\t"
                             "ds_read_b64_tr_b16 %8, %16 offset:4096\n\tds_read_b64_tr_b16 %9, %17 offset:4096\n\tds_read_b64_tr_b16 %10, %18 offset:4096\n\tds_read_b64_tr_b16 %11, %19 offset:4096\n\t"
                             "ds_read_b64_tr_b16 %12, %20 offset:4096\n\tds_read_b64_tr_b16 %13, %21 offset:4096\n\tds_read_b64_tr_b16 %14, %22 offset:4096\n\tds_read_b64_tr_b16 %15, %23 offset:4096\n\t"
                             "s_waitcnt lgkmcnt(0)"
                             : "=&v"(t00), "=&v"(t01), "=&v"(t10), "=&v"(t11), "=&v"(t20), "=&v"(t21), "=&v"(t30), "=&v"(t31),
                               "=&v"(u00), "=&v"(u01), "=&v"(u10), "=&v"(u11), "=&v"(u20), "=&v"(u21), "=&v"(u30), "=&v"(u31)
                             : "v"(va[0][0] + kt * 8192), "v"(va[0][1] + kt * 8192), "v"(va[1][0] + kt * 8192), "v"(va[1][1] + kt * 8192),
                               "v"(va[2][0] + kt * 8192), "v"(va[2][1] + kt * 8192), "v"(va[3][0] + kt * 8192), "v"(va[3][1] + kt * 8192) : "memory");
                const bf16x8 p0 = __builtin_bit_cast(bf16x8, pf[kt][0]), p1 = __builtin_bit_cast(bf16x8, pf[kt][1]);
                O[0] = MFMA32(cat4(t00, t01), p0, O[0]); O[1] = MFMA32(cat4(t10, t11), p0, O[1]); O[2] = MFMA32(cat4(t20, t21), p0, O[2]); O[3] = MFMA32(cat4(t30, t31), p0, O[3]);
                O[0] = MFMA32(cat4(u00, u01), p1, O[0]); O[1] = MFMA32(cat4(u10, u11), p1, O[1]); O[2] = MFMA32(cat4(u20, u21), p1, O[2]); O[3] = MFMA32(cat4(u30, u31), p1, O[3]);
            }
        }
        const float inv = 1.f / sum;
        bf16_t* op = OpB + (size_t)pat * MTOK * AW + qrow * AW + hh * 128 + 4 * h;
#pragma unroll
        for (int c = 0; c < 4; ++c)
#pragma unroll
            for (int g = 0; g < 4; ++g) { u32x2 w; w.x = pk2(O[c][4 * g] * inv, O[c][4 * g + 1] * inv); w.y = pk2(O[c][4 * g + 2] * inv, O[c][4 * g + 3] * inv);
                *(u32x2*)(op + 32 * c + 8 * g) = w; }
        if (h == 0) LseB[(size_t)pat * MTOK * 8 + qrow * 8 + hh] = (mx + __builtin_amdgcn_logf(sum)) * LN2F;
        __syncthreads();
#undef TILE_BASE
    }
}

__device__ __forceinline__ void phase_combine(const Params& P, int layer_i) {
    unsigned char* ws = P.ws; asm volatile("" : "+s"(ws));
    int tid_ = threadIdx.x; asm volatile("" : "+v"(tid_));
    const int tid2 = tid_;
    const bf16_t* sza = (const bf16_t*)(ws + WS_SZA); const bf16_t* pp = (const bf16_t*)(ws + WS_PP); const bf16_t* gz = (const bf16_t*)(ws + WS_GZ);
    const bf16_t* Op = (const bf16_t*)(ws + WS_OP); const float* Lse = (const float*)(ws + WS_LSE); bf16_t* Y = (bf16_t*)(ws + WS_H);
    const float* cw = inp(P, I_AB_CONV) + (size_t)layer_i * 3 * AW;
    for (int item = blockIdx.x; item < NB * 8 * 8; item += gridDim.x) {
        const int b = item >> 6, hh = (item >> 3) & 7, seg = item & 7, s0 = seg * 512;
        const int cl = tid2 & 15, col = hh * 128 + cl * 8;
        float w0[8], w1[8], w2[8];
#pragma unroll
        for (int e = 0; e < 8; ++e) { w0[e] = cw[col + e]; w1[e] = cw[AW + col + e]; w2[e] = cw[2 * AW + col + e]; }
#pragma unroll 2
        for (int pass = 0; pass < 16; ++pass) {
            const int pos = s0 + pass * 32 + (tid2 >> 4); const size_t row = (size_t)b * SEQ + pos;
            const float l0 = Lse[row * 8 + hh], l1 = Lse[(size_t)MTOK * 8 + row * 8 + hh], l2 = Lse[(size_t)2 * MTOK * 8 + row * 8 + hh];
            const float lm = fmaxf(l0, fmaxf(l1, l2));
            float e0 = fexp2((l0 - lm) * 1.4426950408889634f), e1 = fexp2((l1 - lm) * 1.4426950408889634f), e2 = fexp2((l2 - lm) * 1.4426950408889634f);
            const float ei = 1.f / (e0 + e1 + e2); e0 *= ei; e1 *= ei; e2 *= ei;
            const u32x4 a0 = *(const u32x4*)(Op + row * AW + col), a1 = *(const u32x4*)(Op + (size_t)MTOK * AW + row * AW + col), a2 = *(const u32x4*)(Op + (size_t)2 * MTOK * AW + row * AW + col);
            const u32x4 zz = *(const u32x4*)(sza + row * AW + col);
            u32x4 ya;
#pragma unroll
            for (int e = 0; e < 4; ++e) {
                const float lo = (e0 * bf_lo(a0[e]) + e1 * bf_lo(a1[e]) + e2 * bf_lo(a2[e])) * bf_lo(zz[e]);
                const float hi = (e0 * bf_hi(a0[e]) + e1 * bf_hi(a1[e]) + e2 * bf_hi(a2[e])) * bf_hi(zz[e]);
                ya[e] = pk2(lo, hi); }
            *(u32x4*)(Y + row * DM + col) = ya;
            const u32x4 pc = *(const u32x4*)(pp + row * AW + col);
            u32x4 pm = (u32x4){0u, 0u, 0u, 0u}, pn = (u32x4){0u, 0u, 0u, 0u};
            if (pos > 0) pm = *(const u32x4*)(pp + (row - 1) * AW + col);
            if (pos < SEQ - 1) pn = *(const u32x4*)(pp + (row + 1) * AW + col);
            const u32x4 gg = *(const u32x4*)(gz + row * AW + col);
            u32x4 yb;
#pragma unroll
            for (int e = 0; e < 4; ++e) {
                const float lo = bf_lo(gg[e]) * (w0[2 * e] * bf_lo(pm[e]) + w1[2 * e] * bf_lo(pc[e]) + w2[2 * e] * bf_lo(pn[e]));
                const float hi = bf_hi(gg[e]) * (w0[2 * e + 1] * bf_hi(pm[e]) + w1[2 * e + 1] * bf_hi(pc[e]) + w2[2 * e + 1] * bf_hi(pn[e]));
                yb[e] = pk2(lo, hi); }
            *(u32x4*)(Y + row * DM + AW + col) = yb;
        }
    }
}

constexpr int SG_A = 0, SG_B = 32768, SG_MIX_STRIDE = 1040, SG_STATS = 128 * SG_MIX_STRIDE;
__device__ __forceinline__ void phase_sgu(const Params& P, LAS unsigned char* lds, int layer_i) {
    unsigned char* ws = P.ws; asm volatile("" : "+s"(ws));
    int tid_ = threadIdx.x; asm volatile("" : "+v"(tid_));
    const int tid = tid_, lane = tid & 63, wave = __builtin_amdgcn_readfirstlane(tid >> 6);
    const bf16_t* uz = (const bf16_t*)(ws + WS_UZ); const bf16_t* gv = (const bf16_t*)(ws + WS_GV); const float* stats = (const float*)(ws + WS_STATS);
    const bf16_t* wsb = (const bf16_t*)(ws + WS_WS) + (size_t)layer_i * 8 * 128 * 128;
    const float* lng = inp(P, I_SG_LNG) + layer_i * DM; const float* lnb = inp(P, I_SG_LNB) + layer_i * DM; const float* bs = inp(P, I_SG_BS) + layer_i * 8 * 128;
    bf16_t* Y = (bf16_t*)(ws + WS_H);
    LAS float* st = (LAS float*)(lds + SG_STATS);
    const unsigned lbase = (unsigned)(size_t)lds;
    for (int item = blockIdx.x; item < (MTOK / 128) * 8; item += gridDim.x) {
        const int cn = item >> 3, g = item & 7; const size_t row0 = (size_t)cn * 128;
        { const int rr = tid >> 2, part = tid & 3; const float2* sp = (const float2*)stats + (row0 + rr) * 32 + part * 8; float s1 = 0.f, s2 = 0.f;
#pragma unroll
          for (int i = 0; i < 8; ++i) { const float2 v = sp[i]; s1 += v.x; s2 += v.y; }
          s1 += __shfl_xor(s1, 1); s2 += __shfl_xor(s2, 1); s1 += __shfl_xor(s1, 2); s2 += __shfl_xor(s2, 2);
          const float mu = s1 * (1.f / DM), var = fmaxf(s2 * (1.f / DM) - mu * mu, 0.f);
          if (part == 0) { st[2 * rr] = mu; st[2 * rr + 1] = 1.f / sqrtf(var + 1e-6f); } }
#pragma unroll
        for (int i = 0; i < 4; ++i) { const int n = tid + 512 * i, row = n >> 4, ch = n & 15;
            *(LAS u32x4*)(lds + SG_A + off_b(row, ch)) = *(const u32x4*)(wsb + ((size_t)g * 128 + row) * 128 + ch * 8); }
        __syncthreads();
#pragma unroll
        for (int i = 0; i < 8; ++i) { const int n = tid + 512 * i, row = n >> 5, cc = n & 31, c0 = g * 256 + cc * 8;
            const u32x4 v = *(const u32x4*)(gv + (row0 + row) * DM + c0);
            const float mu = st[2 * row], rs = st[2 * row + 1];
            const f32x4 g0 = *(const f32x4*)(lng + c0), g1 = *(const f32x4*)(lng + c0 + 4), b0 = *(const f32x4*)(lnb + c0), b1 = *(const f32x4*)(lnb + c0 + 4);
            u32x4 o;
            o.x = pk2((bf_lo(v.x) - mu) * rs * g0.x + b0.x, (bf_hi(v.x) - mu) * rs * g0.y + b0.y); o.y = pk2((bf_lo(v.y) - mu) * rs * g0.z + b0.z, (bf_hi(v.y) - mu) * rs * g0.w + b0.w);
            o.z = pk2((bf_lo(v.z) - mu) * rs * g1.x + b1.x, (bf_hi(v.z) - mu) * rs * g1.y + b1.y); o.w = pk2((bf_lo(v.w) - mu) * rs * g1.z + b1.z, (bf_hi(v.w) - mu) * rs * g1.w + b1.w);
            *(LAS u32x4*)(lds + SG_B + (cc >> 4) * 32768 + off_b(row, cc & 15)) = o; }
        __syncthreads();
        const unsigned h = lane >> 5, blk = (lane >> 4) & 1, qq = (lane & 15) >> 2, pp = lane & 3;
        const unsigned bimg = lbase + SG_B + (wave >> 2) * 32768; const int ct = wave & 3;
        bf16x8 bf[8];
#pragma unroll
        for (int ks = 0; ks < 8; ++ks) {
            const u16x4 t0 = tr_read(bimg + off_b(16 * ks + 8 * h + qq, 4 * ct + 2 * blk + (pp >> 1)) + 8 * (pp & 1));
            const u16x4 t1 = tr_read(bimg + off_b(16 * ks + 8 * h + 4 + qq, 4 * ct + 2 * blk + (pp >> 1)) + 8 * (pp & 1));
            bf[ks] = cat4(t0, t1); }
        f32x16 acc[4];
#pragma unroll
        for (int tt = 0; tt < 4; ++tt) {
#pragma unroll
            for (int i = 0; i < 16; ++i) acc[tt][i] = 0.f;
#pragma unroll
            for (int ks = 0; ks < 8; ++ks) { const bf16x8 af = *(const LAS bf16x8*)(lds + SG_A + off_b(32 * tt + (lane & 31), 2 * ks + h)); acc[tt] = MFMA32(af, bf[ks], acc[tt]); }
        }
        __syncthreads();
#pragma unroll
        for (int tt = 0; tt < 4; ++tt)
#pragma unroll
            for (int i = 0; i < 16; ++i) { const int t = 32 * tt + (i & 3) + 8 * (i >> 2) + 4 * h;
                *(LAS float*)(lds + t * SG_MIX_STRIDE + (32 * wave + (lane & 31)) * 4) = acc[tt][i] + bs[g * 128 + t]; }
        __syncthreads();
#pragma unroll
        for (int i = 0; i < 8; ++i) { const int n = tid + 512 * i, row = n >> 5, cc = n & 31;
            const f32x4 m0 = *(const LAS f32x4*)(lds + row * SG_MIX_STRIDE + cc * 32), m1 = *(const LAS f32x4*)(lds + row * SG_MIX_STRIDE + cc * 32 + 16);
            const size_t o = (row0 + row) * DM + g * 256 + cc * 8;
            const u32x4 u = *(const u32x4*)(uz + o);
            u32x4 y; y.x = pk2(bf_lo(u.x) * m0.x, bf_hi(u.x) * m0.y); y.y = pk2(bf_lo(u.y) * m0.z, bf_hi(u.y) * m0.w); y.z = pk2(bf_lo(u.z) * m1.x, bf_hi(u.z) * m1.y); y.w = pk2(bf_lo(u.w) * m1.z, bf_hi(u.w) * m1.w);
            *(u32x4*)(Y + o) = y; }
        __syncthreads();
    }
}

#define XB_TMO      128
#define XB_XCNT(j)  (256  + 64 * (j))
#define XB_XSUB(j)  (1280 + 64 * (j))
#define XB_XGEN(j)  (2304 + 64 * (j))
#define XB_TOP      3328
#define XB_TOPGEN   3392
#define XCD_BAR_WORDS 3456
#define XB_SPIN_CAP (1u << 23)

__device__ __forceinline__ unsigned xb_ld(unsigned* p)              { return __hip_atomic_load(p, __ATOMIC_RELAXED, __HIP_MEMORY_SCOPE_AGENT); }
__device__ __forceinline__ unsigned xb_add(unsigned* p, unsigned v) { return __hip_atomic_fetch_add(p, v, __ATOMIC_RELAXED, __HIP_MEMORY_SCOPE_AGENT); }
__device__ __forceinline__ unsigned xb_xcc_id() { return (unsigned)__builtin_amdgcn_s_getreg((3 << 11) | 20) & 0xFu; }
#define XB_SPIN(cond, bar) do { unsigned _sp = 0; while (cond) { __builtin_amdgcn_s_sleep(1); \
    if ((++_sp & 255u) == 0u) { if (xb_ld(&(bar)[XB_TMO])) break; if (_sp > XB_SPIN_CAP) { atomicAdd(&(bar)[XB_TMO], 1u); break; } } } } while (0)

struct XcdBarrier {
    unsigned* bar; unsigned x;
    volatile LAS unsigned* st;
};

__device__ __forceinline__ XcdBarrier xcd_barrier_post(unsigned* bar, volatile LAS unsigned* st) {
    XcdBarrier b; b.bar = bar; b.x = xb_xcc_id(); b.st = st;
    if (threadIdx.x == 0) (void)xb_add(&bar[XB_XCNT(b.x)], 1u);
    return b;
}
__device__ __forceinline__ void xcd_barrier_complete(unsigned* bar, unsigned x, unsigned& nloc, unsigned& nx) {
    const unsigned G = gridDim.x * gridDim.y * gridDim.z;
    unsigned sum, cnt, mine, sp = 0u;
    for (;;) {
        sum = 0u; cnt = 0u; mine = 0u;
#pragma unroll
        for (unsigned j = 0; j < 16; ++j) { const unsigned c = xb_ld(&bar[XB_XCNT(j)]); sum += c; cnt += (c > 0u) ? 1u : 0u; mine = (j == x) ? c : mine; }
        if (sum == G) break;
        __builtin_amdgcn_s_sleep(1);
        if ((++sp & 255u) == 0u) { if (xb_ld(&bar[XB_TMO])) break; if (sp > XB_SPIN_CAP) { atomicAdd(&bar[XB_TMO], 1u); break; } }
    }
    nloc = mine > 0u ? mine : 1u; nx = cnt > 0u ? cnt : 1u;
}

__device__ __forceinline__ void xcd_barrier(const XcdBarrier& b) {
    asm volatile("s_waitcnt vmcnt(0)" ::: "memory");
    __syncthreads();
    if (threadIdx.x == 0) {
        unsigned* bar = b.bar;
        __builtin_amdgcn_s_waitcnt(0);
        unsigned nloc = b.st[0], nx = b.st[1];
        if (nloc == 0u) { xcd_barrier_complete(bar, b.x, nloc, nx); b.st[0] = nloc; b.st[1] = nx; }
        const unsigned old = xb_add(&bar[XB_XSUB(b.x)], 1u);
        const unsigned gen = old / nloc;
        if (old + 1u == (gen + 1u) * nloc) {
            __builtin_amdgcn_fence(__ATOMIC_RELEASE, "agent");
            asm volatile("s_waitcnt vmcnt(0)" ::: "memory");
            const unsigned og = xb_add(&bar[XB_TOP], 1u);
            const unsigned tg = og / nx;
            if (og + 1u == (tg + 1u) * nx) xb_add(&bar[XB_TOPGEN], 1u);
            else XB_SPIN(xb_ld(&bar[XB_TOPGEN]) == tg, bar);
            __builtin_amdgcn_fence(__ATOMIC_ACQUIRE, "agent");
            xb_add(&bar[XB_XGEN(b.x)], 1u);
            asm volatile("s_waitcnt vmcnt(0)" ::: "memory");
        } else {
            XB_SPIN(xb_ld(&bar[XB_XGEN(b.x)]) == gen, bar);
            __builtin_amdgcn_fence(__ATOMIC_ACQUIRE, "agent");
            asm volatile("s_waitcnt vmcnt(0)" ::: "memory");
        }
    }
    __syncthreads();
}


template <class Epi> __device__ __forceinline__ void run_gemm(LAS unsigned char* lds, const bf16_t* A, const bf16_t* Bt, int N, const Epi& E, int pm_mask = -1) {
    pg8::Gemm g; g.A = A; g.Bt = Bt; g.M = MTOK; g.N = N; g.K = DM; g.pm_mask = pm_mask;
    pg8::StaticOrder S; S.init(MTOK, N, (int)gridDim.x, (int)blockIdx.x);
    pg8::gemm_phase<Epi, pg8::StaticOrder, true, true>(lds, g, S, E);
}
__global__ __launch_bounds__(512, 2) void mega_fwd(Params P) {
    extern __shared__ __attribute__((aligned(16))) unsigned char shm[];
    LAS unsigned char* lds = (LAS unsigned char*)shm;
    cg::grid_group grid = cg::this_grid();
    volatile LAS unsigned* xst = (volatile LAS unsigned*)(lds + LDS_XB);
    if (threadIdx.x == 0) { xst[0] = 0u; xst[1] = 0u; }
    __syncthreads();
    XcdBarrier xb = xcd_barrier_post((unsigned*)(P.ws + WS_BAR), xst);
    int nsync = 0;
#ifndef PROBE_REP
#define PROBE_REP 0
#endif
#ifndef PROBE_AI
#define PROBE_AI 1
#endif
#ifndef PROBE_AC
#define PROBE_AC 1
#endif
#ifndef PROBE_SYNCS
#define PROBE_SYNCS 0
#endif
    for (int i = 0; i < PROBE_SYNCS; ++i) xcd_barrier(xb);
    for (int ph2 = 2 * P.ph_lo; ph2 < 2 * P.ph_hi; ++ph2) {
        const int ph = ph2 >> 1;
        if (ph2 & 1) {
            const int sub_ = (ph - 1) & 3, L_ = (ph - 1) >> 2; bool rep = false;
            if (ph >= 1 && ph <= 16) { if (sub_ == 0) rep = (PROBE_REP & 1) && L_ == 0; else if (sub_ == 1) rep = PROBE_REP & 2; else if (sub_ == 2) rep = (L_ & 1) ? (PROBE_REP & 8) : (PROBE_REP & 4); else rep = PROBE_REP & 32; }
            if (!rep) continue;
        }
        if (ph2 > 2 * P.ph_lo) { if (P.ph_hi > 1000) grid.sync(); else xcd_barrier(xb); ++nsync; }
        unsigned char* ws = P.ws; asm volatile("" : "+s"(ws));
        float* xbuf = P.out; asm volatile("" : "+s"(xbuf));
        float* mod = (float*)(ws + WS_MOD);
        bf16_t* H = (bf16_t*)(ws + WS_H);
        if (ph == 0) {
#ifndef SKIP_PRO
            phase_prologue(P, lds);
#endif
            continue; }
        if (ph == 17) { phase_final(xbuf, (const bf16_t*)(ws + WS_DL), inp(P, I_FNG), xbuf); continue; }
        const int L = (ph - 1) >> 2, sub = (ph - 1) & 3, li = L >> 1; const bool sg = L & 1;
        const float* modL = mod + (size_t)L * 4 * 6144;
        if (sub == 0) { phase_norm(L < 2 ? inp(P, I_X) : xbuf, L == 0 ? nullptr : (const bf16_t*)(ws + WS_DL), L == 0 ? nullptr : xbuf, (sg ? inp(P, I_SG_NG) : inp(P, I_AB_NG)) + li * DM, modL, H); }
        else if (sub == 1) {
            if (!sg) { EpiAB1 E; E.q = (bf16_t*)(ws + WS_Q); E.k = (bf16_t*)(ws + WS_K); E.v = (bf16_t*)(ws + WS_V); E.sza = (bf16_t*)(ws + WS_SZA); E.pp = (bf16_t*)(ws + WS_PP); E.gz = (bf16_t*)(ws + WS_GZ);
                E.cosT = (const float*)(ws + WS_ROPE); E.sinT = E.cosT + 4096 * 64;

#ifndef SKIP_G1
                run_gemm(lds, H, (const bf16_t*)(ws + WS_WAB_IN + li * SZ_WAB_IN), N_AB, E);
#endif
            }
            else { EpiSG1 E; E.uz = (bf16_t*)(ws + WS_UZ); E.gv = (bf16_t*)(ws + WS_GV); E.stats = (float*)(ws + WS_STATS);

#ifndef SKIP_G2
                run_gemm(lds, H, (const bf16_t*)(ws + WS_WSG_IN + li * SZ_WSG_IN), N_SG, E);
#endif
            }
        } else if (sub == 2) { if (!sg) {
#ifndef SKIP_ATTN
                for (int rep_ = 0; rep_ < PROBE_AI; ++rep_) phase_attn_items(P, lds);
                xcd_barrier(xb);
                for (int rep_ = 0; rep_ < PROBE_AC; ++rep_) phase_combine(P, li);
#endif
            } else {
#ifndef SKIP_SGU
                phase_sgu(P, lds, li);
#endif
            } }
        else { EpiDelta E; E.dl = (bf16_t*)(ws + WS_DL); E.gate = modL + 4096;
#ifdef PROBE_NOSTORE
            if (ph2 & 1) E.dl = nullptr;
#endif

#ifndef SKIP_G3
#ifdef PROBE_NOSTORE
            run_gemm(lds, H, (const bf16_t*)(ws + (sg ? WS_WSG_OUT : WS_WAB_OUT) + li * SZ_WOUT), DM, E, (ph2 & 1) ? PROBE_PMMASK : -1);
#else
            run_gemm(lds, H, (const bf16_t*)(ws + (sg ? WS_WSG_OUT : WS_WAB_OUT) + li * SZ_WOUT), DM, E);
#endif
#endif
        }
    }
}

#ifndef N_LAUNCH_MODE
#define N_LAUNCH_MODE 1
#endif
extern "C" void kernel_launch(void* const* d_in, const int* in_sizes, int n_in, void* d_out, int out_size, void* d_ws, size_t ws_size, hipStream_t stream) {
    static int grid = 0;
    if (grid == 0) {
        if (n_in != 18 || out_size != MTOK * DM || ws_size < WS_END) { fprintf(stderr, "kernel_launch: unexpected shapes (n_in %d, out %d, ws %zu, need %zu)\n", n_in, out_size, ws_size, (size_t)WS_END); grid = -1; return; }
        int dev = 0, cus = 0, per_cu = 0;
        (void)hipGetDevice(&dev); (void)hipDeviceGetAttribute(&cus, hipDeviceAttributeMultiprocessorCount, dev);
        if (hipFuncSetAttribute((const void*)mega_fwd, hipFuncAttributeMaxDynamicSharedMemorySize, LDS_BYTES) != hipSuccess) { fprintf(stderr, "kernel_launch: hipFuncSetAttribute failed\n"); grid = -1; return; }
        if (hipOccupancyMaxActiveBlocksPerMultiprocessor(&per_cu, (const void*)mega_fwd, NTHR, LDS_BYTES) != hipSuccess || per_cu < 1) { fprintf(stderr, "kernel_launch: occupancy query says %d\n", per_cu); per_cu = 1; }
        (void)hipGetLastError();
        grid = cus * 1;
    }
    if (grid < 0) return;
    (void)hipMemsetAsync((unsigned char*)d_ws + WS_MOD, 0, SZ_MOD + SZ_BAR, stream);
    Params p{};
    for (int i = 0; i < 18; ++i) p.in[i] = (const float*)d_in[i];
    p.out = (float*)d_out; p.ws = (unsigned char*)d_ws;
#if N_LAUNCH_MODE == 1
    p.ph_lo = 0; p.ph_hi = 18;
    void* args[] = {&p};
    hipError_t e = hipLaunchCooperativeKernel((const void*)mega_fwd, dim3(grid), dim3(NTHR), args, LDS_BYTES, stream);
    if (e != hipSuccess) fprintf(stderr, "cooperative launch failed: %s (grid %d)\n", hipGetErrorString(e), grid);
#else
    for (int ph = 0; ph < 18; ++ph) { p.ph_lo = ph; p.ph_hi = ph + 1; hipLaunchKernelGGL(mega_fwd, dim3(grid), dim3(NTHR), LDS_BYTES, stream, p); }
#endif
}
```

```cpp
#include <hip/hip_runtime.h>
#include <hip/hip_cooperative_groups.h>
#include <cstdio>
#include <cstdint>
namespace cg = cooperative_groups;
namespace pg8 {
#define PG8_LAS __attribute__((address_space(3)))
typedef unsigned short bf16_t;
typedef short bf16x8 __attribute__((ext_vector_type(8)));
typedef float f32x4 __attribute__((ext_vector_type(4)));
typedef unsigned u32x4 __attribute__((ext_vector_type(4)));
constexpr int BM = 256, BK = 64, HALF = 128, HTB = HALF * BK * 2  , STAGE_BYTES = 8 * HTB, NXCD = 8, WGM = 8;

__host__ __device__ __forceinline__ int lds_byte(int r, int c) { const int st = (r >> 4) * 2 + (c >> 5), rr = r & 15, cc = c & 31, ob = rr * 64 + cc * 2; return st * 1024 + (ob ^ (((ob >> 9) & 1) << 5)); }
__host__ __device__ __forceinline__ void stage_rc(int b, int& R, int& C) { const int st = b / 1024, sb = b % 1024, swz = sb ^ (((sb >> 9) & 1) << 5); R = (st >> 1) * 16 + swz / 64; C = (st & 1) * 32 + (swz % 64) / 2; }
__host__ __device__ __forceinline__ int perm32(int rho) { const int n = rho >> 4, i = rho & 15; return 8 * (i >> 2) + 4 * n + (i & 3); }

struct Unit { int pm, pn; };
struct Gemm { const bf16_t* A; const bf16_t* Bt; int M, N, K, pm_mask; };

struct StaticOrder {
    int nM, nN, nwg, G, c;
    __host__ __device__ void init(int M, int N, int G_, int c_) { nM = M / BM; nN = N / BM; nwg = nM * nN; G = G_; c = c_; }
    __host__ __device__ bool next(int i, Unit& u) const {
        const long L = (long)i * G + c; if (L >= nwg) return false;
        int wgid = (int)L; { const int q = nwg / NXCD, r = nwg % NXCD, xcd = wgid % NXCD, off = wgid / NXCD; wgid = (xcd < r ? xcd * (q + 1) : r * (q + 1) + (xcd - r) * q) + off; }
        const int nig = WGM * nN, gid = wgid / nig, fm = gid * WGM, gsz = (nM - fm) < WGM ? (nM - fm) : WGM;
        u.pm = fm + ((wgid % nig) % gsz); u.pn = (wgid % nig) / gsz; return true;
    }
    __device__ __forceinline__ void a_ready(const Unit&) const {}
    __device__ __forceinline__ void done(const Unit&) const {}
};

__device__ __forceinline__ unsigned cvt_pk_bf16(float lo, float hi) { unsigned r; asm volatile("v_cvt_pk_bf16_f32 %0, %1, %2" : "=v"(r) : "v"(lo), "v"(hi)); return r; }
template <class Epi, class Sched, bool ALIGN_EPI = false, bool SP2 = false>
__device__ __forceinline__ void gemm_phase(PG8_LAS unsigned char* lds, const Gemm g, const Sched& S, const Epi& E) {
    int tid_ = threadIdx.x; asm volatile("" : "+v"(tid_));
    const int tid = tid_, wid = __builtin_amdgcn_readfirstlane(tid >> 6), lane = tid & 63, wr = wid >> 2, wc = wid & 3, fr = lane & 15, fq = lane >> 4;
    const int K = g.K, nt = K / BK;
    unsigned voffA[2], voffB[2];
#pragma unroll
    for (int i = 0; i < 2; ++i) { int R, C; stage_rc(tid * 16 + i * 8192, R, C); const int Rb = Epi::PERM ? ((R & ~31) + perm32(R & 31)) : R;
        voffA[i] = (unsigned)(R * K + C) * 2u; voffB[i] = (unsigned)(Rb * K + C) * 2u; }
    const size_t kstep = (size_t)(BK * 2);
    const size_t hstep = (size_t)HALF * K * 2;
    const size_t tstep = 2 * hstep;
    const unsigned ldsw = (unsigned)wid * 1024u;
    const int aoff = lds_byte(wr * 64 + fr, fq * 8), boff = lds_byte(wc * 32 + fr, fq * 8);
#define PG8_SA(b, h) (((b) * 2 + (h)) * HTB)
#define PG8_SB(b, h) ((4 + (b) * 2 + (h)) * HTB)
#define PG8_STAGE(bufoff, gbase, voff) do { _Pragma("unroll") for (int _i = 0; _i < 2; ++_i) \
        __builtin_amdgcn_global_load_lds((const unsigned*)((const char*)(gbase) + (voff)[_i]), (PG8_LAS unsigned*)(lds + (bufoff) + ldsw + _i * 8192), 16, 0, 0); } while (0)
#define PG8_LDA(dst, b, h) do { _Pragma("unroll") for (int m = 0; m < 4; ++m) _Pragma("unroll") for (int k = 0; k < 2; ++k) dst[m][k] = *(const PG8_LAS bf16x8*)(lds + PG8_SA(b, h) + aoff + m * 2048 + k * 1024); } while (0)
#define PG8_LDB(dst, b, h) do { _Pragma("unroll") for (int n = 0; n < 2; ++n) _Pragma("unroll") for (int k = 0; k < 2; ++k) dst[n][k] = *(const PG8_LAS bf16x8*)(lds + PG8_SB(b, h) + boff + n * 2048 + k * 1024); } while (0)
#define PG8_MMA(ai, bj, At, Bt) do { __builtin_amdgcn_s_setprio(1); _Pragma("unroll") for (int m = 0; m < 4; ++m) _Pragma("unroll") for (int n = 0; n < 2; ++n) _Pragma("unroll") for (int k = 0; k < 2; ++k) \
        acc[ai][bj][m][n] = __builtin_amdgcn_mfma_f32_16x16x32_bf16(Bt[n][k], At[m][k], acc[ai][bj][m][n], 0, 0, 0); __builtin_amdgcn_s_setprio(0); } while (0)
#define PG8_WAIT_V(n) asm volatile("s_waitcnt vmcnt(" #n ")" ::: "memory")
#define PG8_WAIT_L(n) asm volatile("s_waitcnt lgkmcnt(" #n ")" ::: "memory")
#define PG8_BAR __builtin_amdgcn_s_barrier()
#define PG8_SCHED __builtin_amdgcn_sched_barrier(0)
    Unit cur, nxt; int ui = 0;
    if (!S.next(0, cur)) return;
    f32x4 acc[2][2][4][2];
#pragma unroll
    for (int a = 0; a < 2; ++a)
#pragma unroll
        for (int b = 0; b < 2; ++b)
#pragma unroll
            for (int m = 0; m < 4; ++m)
#pragma unroll
                for (int n = 0; n < 2; ++n) acc[a][b][m][n] = (f32x4){0.f, 0.f, 0.f, 0.f};
    bf16x8 At[4][2], B0[2][2], B1[2][2];
    const char* cA = (const char*)g.A + (size_t)(cur.pm & g.pm_mask) * tstep; const char* cB = (const char*)g.Bt + (size_t)cur.pn * tstep;
    S.a_ready(cur);
    if constexpr (SP2) {
        PG8_STAGE(PG8_SB(0, 0), cB, voffB); PG8_STAGE(PG8_SB(0, 1), cB + hstep, voffB); PG8_STAGE(PG8_SA(0, 0), cA, voffA); PG8_STAGE(PG8_SA(0, 1), cA + hstep, voffA);
        if (wr == 1) PG8_BAR;
        PG8_WAIT_V(2); PG8_BAR;
        PG8_STAGE(PG8_SB(1, 0), cB + kstep, voffB); PG8_STAGE(PG8_SA(1, 0), cA + kstep, voffA); PG8_STAGE(PG8_SB(1, 1), cB + hstep + kstep, voffB);
        PG8_WAIT_V(6); PG8_BAR;
    } else {
        PG8_STAGE(PG8_SB(0, 0), cB, voffB); PG8_STAGE(PG8_SA(0, 0), cA, voffA); PG8_STAGE(PG8_SB(0, 1), cB + hstep, voffB); PG8_STAGE(PG8_SA(0, 1), cA + hstep, voffA);
        if (wr == 1) PG8_BAR;
        PG8_WAIT_V(4); PG8_BAR;
        PG8_STAGE(PG8_SB(1, 0), cB + kstep, voffB); PG8_STAGE(PG8_SA(1, 0), cA + kstep, voffA); PG8_STAGE(PG8_SB(1, 1), cB + hstep + kstep, voffB);
        PG8_WAIT_V(6); PG8_BAR;
    }
    for (;;) {
        const bool has_next = S.next(ui + 1, nxt);
        const char* nA = has_next ? (const char*)g.A + (size_t)(nxt.pm & g.pm_mask) * tstep : cA; const char* nB = has_next ? (const char*)g.Bt + (size_t)nxt.pn * tstep : cB;
        for (int t = 0; t < nt; t += 2) {
            const bool last = (t == nt - 2);
            const char* a1 = cA + (size_t)(t + 1) * kstep;
            const char* a2 = last ? nA : cA + (size_t)(t + 2) * kstep; const char* b2 = last ? nB : cB + (size_t)(t + 2) * kstep;
            const char* a3 = a2 + kstep; const char* b3 = b2 + kstep;
            if (last && has_next) S.a_ready(nxt);
            if constexpr (SP2) {
            PG8_LDB(B0, 0, 0); PG8_LDB(B1, 0, 1); PG8_SCHED; PG8_LDA(At, 0, 0); PG8_STAGE(PG8_SA(1, 1), a1 + hstep, voffA);
            PG8_WAIT_V(8); PG8_WAIT_L(0); PG8_BAR; PG8_MMA(0, 0, At, B0); PG8_MMA(0, 1, At, B1); PG8_BAR; PG8_SCHED;
            PG8_LDA(At, 0, 1); PG8_STAGE(PG8_SB(0, 0), b2, voffB); PG8_STAGE(PG8_SB(0, 1), b2 + hstep, voffB); PG8_STAGE(PG8_SA(0, 0), a2, voffA);
            PG8_WAIT_V(8); PG8_WAIT_L(0); PG8_BAR; PG8_MMA(1, 0, At, B0); PG8_MMA(1, 1, At, B1); PG8_BAR; PG8_SCHED;
            PG8_LDB(B0, 1, 0); PG8_LDB(B1, 1, 1); PG8_SCHED; PG8_LDA(At, 1, 0); PG8_STAGE(PG8_SA(0, 1), a2 + hstep, voffA);
            PG8_WAIT_V(8); PG8_WAIT_L(0); PG8_BAR; PG8_MMA(0, 0, At, B0); PG8_MMA(0, 1, At, B1); PG8_BAR; PG8_SCHED;
            PG8_LDA(At, 1, 1); PG8_STAGE(PG8_SB(1, 0), b3, voffB); PG8_STAGE(PG8_SB(1, 1), b3 + hstep, voffB); PG8_STAGE(PG8_SA(1, 0), a3, voffA);
            PG8_WAIT_V(8); PG8_WAIT_L(0); PG8_BAR; PG8_MMA(1, 0, At, B0); PG8_MMA(1, 1, At, B1); PG8_BAR; PG8_SCHED;
            } else {
            PG8_LDB(B0, 0, 0); PG8_SCHED; PG8_LDA(At, 0, 0); PG8_STAGE(PG8_SA(1, 1), a1 + hstep, voffA);
            PG8_WAIT_L(8); PG8_BAR; PG8_WAIT_L(0); PG8_MMA(0, 0, At, B0); PG8_BAR; PG8_SCHED;
            PG8_LDB(B1, 0, 1); PG8_STAGE(PG8_SB(0, 0), b2, voffB);
            PG8_BAR; PG8_WAIT_L(0); PG8_MMA(0, 1, At, B1); PG8_BAR;
            PG8_LDA(At, 0, 1); PG8_STAGE(PG8_SA(0, 0), a2, voffA);
            PG8_BAR; PG8_WAIT_L(0); PG8_MMA(1, 0, At, B0); PG8_BAR; PG8_SCHED;
            PG8_STAGE(PG8_SB(0, 1), b2 + hstep, voffB);
            PG8_WAIT_V(6); PG8_BAR; PG8_MMA(1, 1, At, B1); PG8_BAR;
            PG8_LDB(B0, 1, 0); PG8_SCHED; PG8_LDA(At, 1, 0); PG8_STAGE(PG8_SA(0, 1), a2 + hstep, voffA);
            PG8_WAIT_L(8); PG8_BAR; PG8_WAIT_L(0); PG8_MMA(0, 0, At, B0); PG8_BAR; PG8_SCHED;
            PG8_LDB(B1, 1, 1); PG8_STAGE(PG8_SB(1, 0), b3, voffB);
            PG8_BAR; PG8_WAIT_L(0); PG8_MMA(0, 1, At, B1); PG8_BAR;
            PG8_LDA(At, 1, 1); PG8_STAGE(PG8_SA(1, 0), a3, voffA);
            PG8_BAR; PG8_WAIT_L(0); PG8_MMA(1, 0, At, B0); PG8_BAR; PG8_SCHED;
            PG8_STAGE(PG8_SB(1, 1), b3 + hstep, voffB);
            PG8_WAIT_V(6); PG8_BAR; PG8_MMA(1, 1, At, B1); PG8_BAR;
            }
        }
        if constexpr (ALIGN_EPI) { if (wr == 0) PG8_BAR; }
        if constexpr (!Epi::AFTER_DRAIN) { E(acc, cur, wr, wc, fr, fq); S.done(cur); }
        if (!has_next) break;
#pragma unroll
        for (int a = 0; a < 2; ++a)
#pragma unroll
            for (int b = 0; b < 2; ++b)
#pragma unroll
                for (int m = 0; m < 4; ++m)
#pragma unroll
                    for (int n = 0; n < 2; ++n) acc[a][b][m][n] = (f32x4){0.f, 0.f, 0.f, 0.f};
        cur = nxt; cA = nA; cB = nB; ++ui;
        if constexpr (ALIGN_EPI) { if (wr == 1) PG8_BAR; }
    }
    PG8_WAIT_V(0);
    if constexpr (!ALIGN_EPI) { if (wr == 0) PG8_BAR; }
    PG8_BAR;
    if constexpr (Epi::AFTER_DRAIN) { E.fused(acc, cur, wr, wc, fr, fq, lds, wid, lane); S.done(cur); }
#undef PG8_SA
#undef PG8_SB
#undef PG8_STAGE
#undef PG8_LDA
#undef PG8_LDB
#undef PG8_MMA
#undef PG8_WAIT_V
#undef PG8_WAIT_L
#undef PG8_BAR
#undef PG8_SCHED
}
}

#define LAS __attribute__((address_space(3)))
typedef unsigned short bf16_t;
typedef short bf16x8 __attribute__((ext_vector_type(8)));
typedef float f32x4 __attribute__((ext_vector_type(4)));
typedef float f32x16 __attribute__((ext_vector_type(16)));
typedef unsigned u32x4 __attribute__((ext_vector_type(4)));
typedef unsigned u32x2 __attribute__((ext_vector_type(2)));
typedef unsigned short u16x4 __attribute__((ext_vector_type(4)));

constexpr int DM = 2048, NB = 4, SEQ = 4096, MTOK = NB * SEQ;
constexpr int AW = 1024;
constexpr int N_AB = 8192, N_SG = 6144;
constexpr int NWAVES = 8, NTHR = 512;
constexpr int LDS_BYTES = 135168;
constexpr int LDS_XB = LDS_BYTES - 16;
constexpr float QSCALE = 0.08838834764831845f * 1.4426950408889634f;
constexpr float LN2F = 0.6931471805599453f;

constexpr size_t SZ_WAB_IN = (size_t)N_AB * DM * 2, SZ_WOUT = (size_t)DM * DM * 2, SZ_WSG_IN = (size_t)N_SG * DM * 2;
constexpr size_t WS_WAB_IN = 0;
constexpr size_t WS_WAB_OUT = WS_WAB_IN + 2 * SZ_WAB_IN;
constexpr size_t WS_WSG_IN = WS_WAB_OUT + 2 * SZ_WOUT;
constexpr size_t WS_WSG_OUT = WS_WSG_IN + 2 * SZ_WSG_IN;
constexpr size_t WS_WS = WS_WSG_OUT + 2 * SZ_WOUT;
constexpr size_t WS_MOD = WS_WS + (size_t)2 * 8 * 128 * 128 * 2;
constexpr size_t SZ_MOD = (size_t)4 * 4 * 6144 * 4;
constexpr size_t WS_BAR = WS_MOD + SZ_MOD;
constexpr size_t SZ_BAR = 16384;
constexpr size_t WS_ROPE = WS_BAR + SZ_BAR;
constexpr size_t WS_STATS = WS_ROPE + (size_t)2 * 4096 * 64 * 4;
constexpr size_t WS_H = WS_STATS + (size_t)MTOK * 32 * 8;
constexpr size_t SZ_ACT = (size_t)MTOK * DM * 2;
constexpr size_t WS_P = WS_H + SZ_ACT;
constexpr size_t SZ_A = (size_t)MTOK * AW * 2;
constexpr size_t WS_Q = WS_P, WS_K = WS_P + SZ_A, WS_V = WS_P + 2 * SZ_A, WS_SZA = WS_P + 3 * SZ_A, WS_PP = WS_P + 4 * SZ_A, WS_GZ = WS_P + 5 * SZ_A;
constexpr size_t WS_OP = WS_P + 6 * SZ_A;
constexpr size_t WS_LSE = WS_OP + 3 * SZ_A;
constexpr size_t WS_END = WS_LSE + (size_t)3 * MTOK * 8 * 4;
constexpr size_t WS_DL = WS_P;
constexpr size_t WS_UZ = WS_P, WS_GV = WS_P + SZ_ACT;

struct Params {
    const float* in[18];
    float* out;
    unsigned char* ws;
    int ph_lo, ph_hi;
};
__device__ __forceinline__ const float* inp(const Params& P, int i) { asm volatile("" : "+s"(i)); return P.in[i]; }
enum { I_X = 0, I_C, I_AB_NG, I_AB_WMOD, I_AB_BMOD, I_AB_WIN, I_AB_CONV, I_AB_WOUT, I_SG_NG, I_SG_WMOD, I_SG_BMOD, I_SG_WIN, I_SG_LNG, I_SG_LNB, I_SG_WS, I_SG_BS, I_SG_WOUT, I_FNG };

__device__ const double kInvFreq[64] = {
1.0, 0.8659643233600653, 0.7498942093324559, 0.6493816315762113, 0.5623413251903491, 0.4869675251658631, 0.4216965034285822, 0.3651741272548377, 0.31622776601683794, 0.27384196342643613, 0.23713737056616552, 0.2053525026457146, 0.1778279410038923, 0.1539926526059492, 0.1333521432163324, 0.11547819846894582, 0.1, 0.08659643233600653, 0.07498942093324558, 0.06493816315762113, 0.05623413251903491, 0.04869675251658631, 0.042169650342858224, 0.03651741272548377, 0.03162277660168379, 0.027384196342643614, 0.023713737056616554, 0.02053525026457146, 0.01778279410038923, 0.01539926526059492, 0.01333521432163324, 0.011547819846894581, 0.01, 0.008659643233600654, 0.007498942093324558, 0.006493816315762113, 0.005623413251903491, 0.004869675251658631, 0.004216965034285823, 0.003651741272548377, 0.0031622776601683794, 0.0027384196342643613, 0.0023713737056616554, 0.002053525026457146, 0.0017782794100389228, 0.001539926526059492, 0.001333521432163324, 0.0011547819846894581, 0.001, 0.0008659643233600654, 0.0007498942093324559, 0.0006493816315762113, 0.0005623413251903491, 0.0004869675251658631, 0.00042169650342858224, 0.0003651741272548377, 0.00031622776601683794, 0.0002738419634264361, 0.00023713737056616554, 0.0002053525026457146, 0.00017782794100389227, 0.0001539926526059492, 0.0001333521432163324, 0.00011547819846894582};

__device__ __forceinline__ unsigned pk2(float lo, float hi) { unsigned r; asm("v_cvt_pk_bf16_f32 %0, %1, %2" : "=v"(r) : "v"(lo), "v"(hi)); return r; }
__device__ __forceinline__ float bf_lo(unsigned u) { return __uint_as_float(u << 16); }
__device__ __forceinline__ float bf_hi(unsigned u) { return __uint_as_float(u & 0xffff0000u); }
__device__ __forceinline__ float fexp2(float x) { return __builtin_amdgcn_exp2f(x); }
__device__ __forceinline__ float frcp(float x) { return __builtin_amdgcn_rcpf(x); }
__device__ __forceinline__ float silu_f(float x) { return x * frcp(1.f + fexp2(-1.4426950408889634f * x)); }
__device__ __forceinline__ float gelu_f(float x) { const float u = 0.7978845608028654f * (x + 0.044715f * x * x * x); return x * frcp(1.f + fexp2(-2.885390081777927f * u)); }
__device__ __forceinline__ float gelu_silu_f(float u, float z) { const float t = 0.7978845608028654f * (u + 0.044715f * u * u * u); return u * z * frcp((1.f + fexp2(-2.885390081777927f * t)) * (1.f + fexp2(-1.4426950408889634f * z))); }
__device__ __forceinline__ float wave_sum(float v) {
#pragma unroll
    for (int o = 1; o < 64; o <<= 1) v += __shfl_xor(v, o);
    return v;
}
__device__ __forceinline__ void lds_wait() { asm volatile("s_waitcnt lgkmcnt(0)" ::: "memory"); }
__device__ __forceinline__ unsigned off_b(unsigned row, unsigned ch) { return 256u * row + 16u * (ch ^ (((row & 3) << 2) | ((row >> 2) & 3))); }
__device__ __forceinline__ u16x4 tr_read(unsigned lds_addr) { u16x4 r; asm volatile("ds_read_b64_tr_b16 %0, %1\n\ts_waitcnt lgkmcnt(0)" : "=&v"(r) : "v"(lds_addr) : "memory"); return r; }
__device__ __forceinline__ bf16x8 cat4(u16x4 a, u16x4 b) { bf16x8 r; r[0] = a[0]; r[1] = a[1]; r[2] = a[2]; r[3] = a[3]; r[4] = b[0]; r[5] = b[1]; r[6] = b[2]; r[7] = b[3]; return r; }

using pg8::Unit;
__device__ __forceinline__ void st8(bf16_t* p, const float (&v)[8]) { u32x4 w; w.x = pk2(v[0], v[1]); w.y = pk2(v[2], v[3]); w.z = pk2(v[4], v[5]); w.w = pk2(v[6], v[7]); *(u32x4*)p = w; }

struct EpiAB1 {
    static constexpr bool PERM = true, AFTER_DRAIN = false;
    bf16_t *q, *k, *v, *sza, *pp, *gz; const float *cosT, *sinT;
    __device__ __forceinline__ void operator()(const f32x4 (&acc)[2][2][4][2], const Unit& u, int wr, int wc, int fr, int fq) const {
        const int row0 = u.pm * 256 + wr * 64 + fr, pn = u.pn;
        if (pn < 8) {
            bf16_t* dst = pn < 4 ? q : k; const float sc = pn < 4 ? QSCALE : 1.f;
            const int head = (pn & 3) * 2 + (wc >> 1), i0 = 32 * (wc & 1) + 8 * fq;
#pragma unroll
            for (int ai = 0; ai < 2; ++ai)
#pragma unroll
                for (int m = 0; m < 4; ++m) {
                    const int row = row0 + ai * 128 + m * 16, pos = row & (SEQ - 1);
                    const f32x4* cp = (const f32x4*)(cosT + pos * 64 + i0); const f32x4* sp = (const f32x4*)(sinT + pos * 64 + i0);
                    const f32x4 c0 = cp[0], c1 = cp[1], s0 = sp[0], s1 = sp[1];
                    float o1[8], o2[8];
#pragma unroll
                    for (int j = 0; j < 4; ++j) {
                        const float a0 = acc[ai][0][m][0][j], b0 = acc[ai][1][m][0][j], a1 = acc[ai][0][m][1][j], b1 = acc[ai][1][m][1][j];
                        o1[j] = (a0 * c0[j] - b0 * s0[j]) * sc; o2[j] = (b0 * c0[j] + a0 * s0[j]) * sc;
                        o1[4 + j] = (a1 * c1[j] - b1 * s1[j]) * sc; o2[4 + j] = (b1 * c1[j] + a1 * s1[j]) * sc;
                    }
                    bf16_t* rp = dst + (size_t)row * AW + head * 128 + i0;
                    st8(rp, o1); st8(rp + 64, o2);
                }
        } else if (pn < 16) {
            const bool isv = pn < 12; bf16_t* dst = isv ? v : sza; const int colt = (pn & 3) * 256 + wc * 32 + 8 * fq;
#pragma unroll
            for (int ai = 0; ai < 2; ++ai)
#pragma unroll
                for (int m = 0; m < 4; ++m) {
                    bf16_t* rp = dst + (size_t)(row0 + ai * 128 + m * 16) * AW + colt;
#pragma unroll
                    for (int bj = 0; bj < 2; ++bj) { float o[8];
#pragma unroll
                        for (int j = 0; j < 4; ++j) { const float a = acc[ai][bj][m][0][j], b = acc[ai][bj][m][1][j]; o[j] = isv ? a : silu_f(a); o[4 + j] = isv ? b : silu_f(b); }
                        st8(rp + bj * 128, o); }
                }
        } else {
            const bool isp = wc < 2; bf16_t* dst = isp ? pp : gz; const int colt = (pn - 16) * 64 + (wc & 1) * 32 + 8 * fq;
#pragma unroll
            for (int ai = 0; ai < 2; ++ai)
#pragma unroll
                for (int m = 0; m < 4; ++m) { float o[8];
#pragma unroll
                    for (int j = 0; j < 4; ++j) { const float a0 = acc[ai][0][m][0][j], b0 = acc[ai][1][m][0][j], a1 = acc[ai][0][m][1][j], b1 = acc[ai][1][m][1][j];
                        o[j] = isp ? a0 * b0 : a0 * silu_f(b0); o[4 + j] = isp ? a1 * b1 : a1 * silu_f(b1); }
                    st8(dst + (size_t)(row0 + ai * 128 + m * 16) * AW + colt, o); }
        }
    }
};
struct EpiSG1 {
    static constexpr bool PERM = true, AFTER_DRAIN = false;
    bf16_t *uz, *gv; float* stats;
    __device__ __forceinline__ void operator()(const f32x4 (&acc)[2][2][4][2], const Unit& u, int wr, int wc, int fr, int fq) const {
        const int row0 = u.pm * 256 + wr * 64 + fr, pn = u.pn;
        if (pn < 16) {
            const int colt = pn * 128 + wc * 32 + 8 * fq;
#pragma unroll
            for (int ai = 0; ai < 2; ++ai)
#pragma unroll
                for (int m = 0; m < 4; ++m) { float o[8];
#pragma unroll
                    for (int j = 0; j < 4; ++j) { o[j] = gelu_silu_f(acc[ai][0][m][0][j], acc[ai][1][m][0][j]); o[4 + j] = gelu_silu_f(acc[ai][0][m][1][j], acc[ai][1][m][1][j]); }
                    st8(uz + (size_t)(row0 + ai * 128 + m * 16) * DM + colt, o); }
        } else {
            const int colt = (pn - 16) * 256 + wc * 32 + 8 * fq;
#pragma unroll
            for (int ai = 0; ai < 2; ++ai)
#pragma unroll
                for (int m = 0; m < 4; ++m) { const int row = row0 + ai * 128 + m * 16; float s1 = 0.f, s2 = 0.f;
#pragma unroll
                    for (int bj = 0; bj < 2; ++bj) { float o[8];
#pragma unroll
                        for (int j = 0; j < 4; ++j) { o[j] = gelu_f(acc[ai][bj][m][0][j]); o[4 + j] = gelu_f(acc[ai][bj][m][1][j]); }
#pragma unroll
                        for (int j = 0; j < 8; ++j) { s1 += o[j]; s2 += o[j] * o[j]; }
                        st8(gv + (size_t)row * DM + colt + bj * 128, o); }
                    s1 += __shfl_xor(s1, 16); s2 += __shfl_xor(s2, 16); s1 += __shfl_xor(s1, 32); s2 += __shfl_xor(s2, 32);
                    if (fq == 0) { float2 w; w.x = s1; w.y = s2; *(float2*)(stats + ((size_t)row * 32 + (pn - 16) * 4 + wc) * 2) = w; }
                }
        }
    }
};
struct EpiDelta {
    static constexpr bool PERM = true, AFTER_DRAIN = false;
    bf16_t* dl; const float* gate;
    __device__ __forceinline__ void operator()(const f32x4 (&acc)[2][2][4][2], const Unit& u, int wr, int wc, int fr, int fq) const {
        if (!dl) return;
        const int row0 = u.pm * 256 + wr * 64 + fr, col0 = u.pn * 256 + wc * 32 + 8 * fq;
        const float* gp = gate + (size_t)(u.pm >> 4) * 6144 + col0;
        f32x4 g[2][2];
#pragma unroll
        for (int bj = 0; bj < 2; ++bj)
#pragma unroll
            for (int n = 0; n < 2; ++n) g[bj][n] = *(const f32x4*)(gp + bj * 128 + n * 4);
#pragma unroll
        for (int ai = 0; ai < 2; ++ai)
#pragma unroll
            for (int m = 0; m < 4; ++m) { bf16_t* rp = dl + (size_t)(row0 + ai * 128 + m * 16) * DM + col0;
#pragma unroll
                for (int bj = 0; bj < 2; ++bj) { float o[8];
#pragma unroll
                    for (int j = 0; j < 4; ++j) { o[j] = g[bj][0][j] * acc[ai][bj][m][0][j]; o[4 + j] = g[bj][1][j] * acc[ai][bj][m][1][j]; }
                    st8(rp + bj * 128, o); } }
    }
};

__device__ __forceinline__ int src_col_ab_in(int n) { const int tile = n >> 8, rho = n & 255;
    if (tile < 8) { const int bj = rho >> 7, w = rho & 127; return tile * 256 + (w >> 6) * 128 + bj * 64 + (w & 63); }
    if (tile < 16) return n;
    return 4096 + (rho >> 6) * 1024 + 64 * (tile - 16) + (rho & 63); }
__device__ __forceinline__ int src_col_sg_in(int n) { const int tile = n >> 8, rho = n & 255;
    if (tile < 16) return rho < 128 ? 128 * tile + rho : 4096 + 128 * tile + (rho - 128);
    return 2048 + (tile - 16) * 256 + rho; }
__device__ __forceinline__ void p0_transpose_item(const float* W, int N, bf16_t* WT, int k0, int n0, int nsrc0, LAS float* scr, int lane) {
    float t[32];
    const float* wp = W + (size_t)(k0 + (lane >> 5)) * N + nsrc0 + (lane & 31);
#pragma unroll
    for (int i = 0; i < 32; ++i) t[i] = wp[(size_t)(2 * i) * N];
#pragma unroll
    for (int i = 0; i < 32; ++i) scr[(2 * i + (lane >> 5)) * 33 + (lane & 31)] = t[i];
    lds_wait();
    const int c = lane & 7;
#pragma unroll
    for (int j = 0; j < 4; ++j) { const int n = (lane >> 3) + 8 * j; const LAS float* s = scr + (8 * c) * 33 + n;
        u32x4 o; o.x = pk2(s[0 * 33], s[1 * 33]); o.y = pk2(s[2 * 33], s[3 * 33]); o.z = pk2(s[4 * 33], s[5 * 33]); o.w = pk2(s[6 * 33], s[7 * 33]);
        *(u32x4*)(WT + (size_t)(n0 + n) * DM + k0 + 8 * c) = o; }
    lds_wait();
}
__device__ __forceinline__ void phase_prologue(const Params& P, LAS unsigned char* lds) {
    int tid_ = threadIdx.x; asm volatile("" : "+v"(tid_));
    const int tid = tid_, lane = tid & 63, wave = __builtin_amdgcn_readfirstlane(tid >> 6);
    const int gw = blockIdx.x * NWAVES + wave, NGW = gridDim.x * NWAVES;
    LAS float* scr = (LAS float*)(lds + wave * 8704);
    unsigned char* ws = P.ws; asm volatile("" : "+s"(ws));
    constexpr int IT_AB_IN = N_AB, IT_OUT = DM, IT_SG_IN = N_SG;
    constexpr int IT_TOTAL = 2 * (IT_AB_IN + IT_OUT + IT_SG_IN + IT_OUT);
#ifndef PROBE_PRO
#define PROBE_PRO 1
#endif
    for (int rep_ = 0; rep_ < PROBE_PRO; ++rep_)
    for (int it = gw; it < IT_TOTAL; it += NGW) {
        int r = it; const float* W; bf16_t* WT; int N, kind;
        if (r < 2 * IT_AB_IN) { const int i = r / IT_AB_IN; r -= i * IT_AB_IN; N = N_AB; kind = 0; W = inp(P, I_AB_WIN) + (size_t)i * DM * N_AB; WT = (bf16_t*)(ws + WS_WAB_IN + i * SZ_WAB_IN); }
        else if ((r -= 2 * IT_AB_IN) < 2 * IT_OUT) { const int i = r / IT_OUT; r -= i * IT_OUT; N = DM; kind = 2; W = inp(P, I_AB_WOUT) + (size_t)i * DM * DM; WT = (bf16_t*)(ws + WS_WAB_OUT + i * SZ_WOUT); }
        else if ((r -= 2 * IT_OUT) < 2 * IT_SG_IN) { const int i = r / IT_SG_IN; r -= i * IT_SG_IN; N = N_SG; kind = 1; W = inp(P, I_SG_WIN) + (size_t)i * DM * N_SG; WT = (bf16_t*)(ws + WS_WSG_IN + i * SZ_WSG_IN); }
        else { r -= 2 * IT_SG_IN; const int i = r / IT_OUT; r -= i * IT_OUT; N = DM; kind = 2; W = inp(P, I_SG_WOUT) + (size_t)i * DM * DM; WT = (bf16_t*)(ws + WS_WSG_OUT + i * SZ_WOUT); }
        const int nblk = N / 32, kb = r / nblk, nb = r % nblk, n0 = nb * 32;
        const int ns = kind == 0 ? src_col_ab_in(n0) : (kind == 1 ? src_col_sg_in(n0) : n0);
        p0_transpose_item(W, N, WT, kb * 64, n0, ns, scr, lane);
    }
    float* mod = (float*)(ws + WS_MOD);
    LAS unsigned char* red = lds + 71680;
    for (int it = blockIdx.x; it < 4 * 8 * 24; it += gridDim.x) {
        const int L = it / 192, r = it % 192, kq = r / 24, cgp = r % 24, col = cgp * 256 + 4 * lane, k0 = kq * 256 + wave * 32;
        const float* W = (L & 1) ? inp(P, I_SG_WMOD) + (size_t)(L >> 1) * DM * 6144 : inp(P, I_AB_WMOD) + (size_t)(L >> 1) * DM * 6144;
        const float* bm = (L & 1) ? inp(P, I_SG_BMOD) + (L >> 1) * 6144 : inp(P, I_AB_BMOD) + (L >> 1) * 6144;
        float sc[4];
#pragma unroll
        for (int b = 0; b < 4; ++b) sc[b] = silu_f(inp(P, I_C)[b * DM + k0 + (lane & 31)]);
        f32x4 a[4];
#pragma unroll
        for (int b = 0; b < 4; ++b) a[b] = (f32x4){0.f, 0.f, 0.f, 0.f};
        const float* wp = W + (size_t)k0 * 6144 + col;
#pragma unroll
        for (int kk = 0; kk < 32; ++kk) { const f32x4 w = *(const f32x4*)(wp + (size_t)kk * 6144);
#pragma unroll
            for (int b = 0; b < 4; ++b) a[b] += __shfl(sc[b], kk) * w; }
        if (kq == 0 && wave == 0) { const f32x4 bv = *(const f32x4*)(bm + col);
#pragma unroll
            for (int b = 0; b < 4; ++b) a[b] += bv; }
#pragma unroll
        for (int b = 0; b < 4; ++b) *(LAS f32x4*)(red + ((wave * 4 + b) * 64 + lane) * 16) = a[b];
        __syncthreads();
#pragma unroll
        for (int q = 0; q < 2; ++q) { const int o = tid + 512 * q, b = o >> 8, c = o & 255; float s = 0.f;
#pragma unroll
            for (int w = 0; w < 8; ++w) s += *(const LAS float*)(red + ((w * 4 + b) * 64 + (c >> 2)) * 16 + (c & 3) * 4);
            atomicAdd(mod + ((size_t)L * 4 + b) * 6144 + cgp * 256 + c, s); }
        __syncthreads();
    }
    float* cosT = (float*)(ws + WS_ROPE); float* sinT = cosT + 4096 * 64;
    bf16_t* wsb = (bf16_t*)(ws + WS_WS);
    for (int idx = blockIdx.x * NTHR + tid; idx < 4096 * 64; idx += gridDim.x * NTHR) {
        const int pos = idx >> 6, i = idx & 63;
        const double rev = (double)pos * kInvFreq[i] * 0.15915494309189535;
        const float fr = (float)(rev - floor(rev));
        cosT[idx] = __builtin_amdgcn_cosf(fr); sinT[idx] = __builtin_amdgcn_sinf(fr);
        const float w0 = inp(P, I_SG_WS)[idx];
        wsb[idx] = (bf16_t)(pk2(w0, 0.f) & 0xffffu);
    }
}

typedef _Float16 f16x4 __attribute__((ext_vector_type(4)));
constexpr int XH_PITCH = 2 * DM;
__device__ __forceinline__ void phase_norm(const float* xin, const _Float16* xin_h, const bf16_t* dl, _Float16* xout, const float* g, const float* mod  , bf16_t* h) {
    int tid_ = threadIdx.x; asm volatile("" : "+v"(tid_));
    const int lane = tid_ & 63, wave = __builtin_amdgcn_readfirstlane(tid_ >> 6);
    const int NW = gridDim.x * NWAVES;
    for (int row0 = blockIdx.x * NWAVES + wave; row0 < MTOK; row0 += 2 * NW) {
        f32x4 v[2][8]; u32x2 d[2][8];
#pragma unroll
        for (int q = 0; q < 2; ++q) { const int row = min(row0 + q * NW, MTOK - 1);
            if (xin_h) { const f16x4* xr = (const f16x4*)(xin_h + (size_t)row * XH_PITCH) + lane;
#pragma unroll
                for (int j = 0; j < 8; ++j) { const f16x4 t = xr[64 * j]; v[q][j] = (f32x4){(float)t.x, (float)t.y, (float)t.z, (float)t.w}; } }
            else { const f32x4* xr = (const f32x4*)(xin + (size_t)row * DM) + lane;
#pragma unroll
                for (int j = 0; j < 8; ++j) v[q][j] = xr[64 * j]; }
            if (dl) { const u32x2* dr = (const u32x2*)(dl + (size_t)row * DM) + lane;
#pragma unroll
                for (int j = 0; j < 8; ++j) d[q][j] = dr[64 * j]; } }
#pragma unroll
        for (int q = 0; q < 2; ++q) { const int row = row0 + q * NW; float s = 0.f;
            if (row >= MTOK) break;
            if (dl) {
#pragma unroll
                for (int j = 0; j < 8; ++j) { v[q][j].x += bf_lo(d[q][j].x); v[q][j].y += bf_hi(d[q][j].x); v[q][j].z += bf_lo(d[q][j].y); v[q][j].w += bf_hi(d[q][j].y); } }
            if (xout) { f16x4* xo = (f16x4*)(xout + (size_t)row * XH_PITCH) + lane;
#pragma unroll
                for (int j = 0; j < 8; ++j) xo[64 * j] = (f16x4){(_Float16)v[q][j].x, (_Float16)v[q][j].y, (_Float16)v[q][j].z, (_Float16)v[q][j].w}; }
#pragma unroll
            for (int j = 0; j < 8; ++j) s += (v[q][j].x * v[q][j].x + v[q][j].y * v[q][j].y) + (v[q][j].z * v[q][j].z + v[q][j].w * v[q][j].w);
            const float rstd = 1.f / sqrtf(wave_sum(s) * (1.f / DM) + 1e-6f);
            const float* mb = mod + (size_t)(row >> 12) * 6144;
            u32x2* o8 = (u32x2*)(h + (size_t)row * DM) + lane;
#pragma unroll
            for (int j = 0; j < 8; ++j) { const int c = 4 * lane + 256 * j;
                const f32x4 gg = *(const f32x4*)(g + c), sh = *(const f32x4*)(mb + c), sc = *(const f32x4*)(mb + 2048 + c);
                const f32x4 y = v[q][j] * rstd * gg * (1.f + sc) + sh;
                u32x2 w; w.x = pk2(y.x, y.y); w.y = pk2(y.z, y.w); o8[64 * j] = w; } }
    }
}
__device__ __forceinline__ void phase_final(const _Float16* xin_h, const bf16_t* dl, const float* g, float* out) {
    int tid_ = threadIdx.x; asm volatile("" : "+v"(tid_));
    const int lane = tid_ & 63, wave = __builtin_amdgcn_readfirstlane(tid_ >> 6);
    const int NW = gridDim.x * NWAVES;
    for (int row0 = blockIdx.x * NWAVES + wave; row0 < MTOK; row0 += 2 * NW) {
        f32x4 v[2][8]; u32x2 d[2][8];
#pragma unroll
        for (int q = 0; q < 2; ++q) { const int row = min(row0 + q * NW, MTOK - 1); const f16x4* xr = (const f16x4*)(xin_h + (size_t)row * XH_PITCH) + lane; const u32x2* dr = (const u32x2*)(dl + (size_t)row * DM) + lane;
#pragma unroll
            for (int j = 0; j < 8; ++j) { const f16x4 t = xr[64 * j]; v[q][j] = (f32x4){(float)t.x, (float)t.y, (float)t.z, (float)t.w}; d[q][j] = dr[64 * j]; } }
        asm volatile("s_waitcnt vmcnt(0)" ::: "memory");
#pragma unroll
        for (int q = 0; q < 2; ++q) { const int row = row0 + q * NW; float s = 0.f;
            if (row >= MTOK) break;
#pragma unroll
            for (int j = 0; j < 8; ++j) { v[q][j].x += bf_lo(d[q][j].x); v[q][j].y += bf_hi(d[q][j].x); v[q][j].z += bf_lo(d[q][j].y); v[q][j].w += bf_hi(d[q][j].y);
                s += (v[q][j].x * v[q][j].x + v[q][j].y * v[q][j].y) + (v[q][j].z * v[q][j].z + v[q][j].w * v[q][j].w); }
            const float rstd = 1.f / sqrtf(wave_sum(s) * (1.f / DM) + 1e-6f);
            f32x4* o = (f32x4*)(out + (size_t)row * DM) + lane;
#pragma unroll
            for (int j = 0; j < 8; ++j) o[64 * j] = v[q][j] * rstd * *(const f32x4*)(g + 4 * lane + 256 * j); }
    }
}

#define MFMA32(a, b, c) __builtin_amdgcn_mfma_f32_32x32x16_bf16((a), (b), (c), 0, 0, 0)
__device__ __forceinline__ void phase_attn_items(const Params& P, LAS unsigned char* lds) {
    unsigned char* ws = P.ws; asm volatile("" : "+s"(ws));
    int tid_ = threadIdx.x; asm volatile("" : "+v"(tid_));
    const int tid = tid_, wave = __builtin_amdgcn_readfirstlane(tid >> 6);
    const bf16_t* Q = (const bf16_t*)(ws + WS_Q); const bf16_t* Kb = (const bf16_t*)(ws + WS_K); const bf16_t* Vb = (const bf16_t*)(ws + WS_V);
    bf16_t* OpB = (bf16_t*)(ws + WS_OP); float* LseB = (float*)(ws + WS_LSE);
    const bool xmap = gridDim.x == 256;
    for (int it = 0; it < (xmap ? 6 : (3 * 512 + (int)gridDim.x - 1) / (int)gridDim.x); ++it) {
        int lane = tid & 63; asm volatile("" : "+v"(lane));
        int pat, b, hh, rc;
        if (xmap) { const int g = it * 32 + (blockIdx.x >> 3), pair = 4 * (blockIdx.x & 7) + g / 48, within = g % 48; pat = within >> 4; rc = within & 15; b = pair >> 3; hh = pair & 7; }
        else { const int item = it * gridDim.x + blockIdx.x; if (item >= 3 * 512) break; pat = item >> 9; const int rem = item & 511; b = rem >> 7; hh = (rem >> 4) & 7; rc = rem & 15; }
        const int dlog = 2 * pat, r = pat == 0 ? 0 : (pat == 1 ? rc >> 2 : rc), ch8 = pat == 0 ? rc : (pat == 1 ? rc & 3 : 0);
        const int ntile = (SEQ >> dlog) >> 5, ql = lane & 31, h = lane >> 5;
        const size_t rowbase = (size_t)b * SEQ;
        const size_t hb = (size_t)hh * 256;
#define TILE_BASE(P_, T_) ((const char*)(P_) + (rowbase + ((size_t)(32 * (T_)) << dlog) + r) * (AW * 2) + hb)
        const int trow = (tid >> 4) & 31, tch = tid & 15;
        const unsigned roff = (unsigned)((trow << dlog) * AW + tch * 8) * 2u;
        const unsigned loff = off_b(trow, tch);
        u32x4 kk[12];
#pragma unroll
        for (int i = 0; i < 12; ++i) { const int T = 8 * ch8 - 2 + i; if (T >= 0 && T < ntile) kk[i] = *(const u32x4*)(TILE_BASE(Kb, T) + roff); else kk[i] = (u32x4){0u, 0u, 0u, 0u}; }
        const int qt = 8 * ch8 + wave;
        const size_t qrow = rowbase + ((size_t)(32 * qt + ql) << dlog) + r;
        bf16x8 qf[8];
        { const bf16_t* Qp = Q + qrow * AW + hh * 128 + 8 * h;
#pragma unroll
          for (int ks = 0; ks < 8; ++ks) qf[ks] = *(const bf16x8*)(Qp + 16 * ks); }
#pragma unroll
        for (int i = 0; i < 12; ++i) *(LAS u32x4*)(lds + i * 8192 + loff) = kk[i];
        u32x4 vv[12];
#pragma unroll
        for (int i = 0; i < 12; ++i) { const int T = 8 * ch8 - 2 + i; if (T >= 0 && T < ntile) vv[i] = *(const u32x4*)(TILE_BASE(Vb, T) + roff); else vv[i] = (u32x4){0u, 0u, 0u, 0u}; }
        __syncthreads();
        f32x16 S[5];
#pragma unroll
        for (int kt = 0; kt < 5; ++kt) {
            const int T = qt + kt - 2; const bool tv = (T >= 0) && (T < ntile);
            f32x16 s;
#pragma unroll
            for (int i = 0; i < 16; ++i) s[i] = 0.f;
            if (tv) {
                const LAS unsigned char* kl = lds + (wave + kt) * 8192;
                bf16x8 kf[8];
#pragma unroll
                for (int ks = 0; ks < 8; ++ks) kf[ks] = *(const LAS bf16x8*)(kl + off_b(ql, 2 * ks + h));
#pragma unroll
                for (int ks = 0; ks < 8; ++ks) s = MFMA32(kf[ks], qf[ks], s);
            }
            S[kt] = s;
        }
        float mx = -1e30f;
#pragma unroll
        for (int kt = 0; kt < 5; ++kt) {
            const int T = qt + kt - 2; const bool tv = (T >= 0) && (T < ntile);
#pragma unroll
            for (int i = 0; i < 16; ++i) {
                const int kl_ = (i & 3) + 8 * (i >> 2) + 4 * h;
                const bool valid = tv && (kt == 0 ? (kl_ >= ql) : (kt == 4 ? (kl_ <= ql) : true));
                const float sv = valid ? S[kt][i] : -1e30f; S[kt][i] = sv; mx = fmaxf(mx, sv);
            }
        }
        mx = fmaxf(mx, __shfl_xor(mx, 32));
        float sum = 0.f;
        u32x4 pf[5][2];
#pragma unroll
        for (int kt = 0; kt < 5; ++kt) {
            float p[16];
#pragma unroll
            for (int i = 0; i < 16; ++i) { p[i] = fexp2(S[kt][i] - mx); sum += p[i]; }
#pragma unroll
            for (int s = 0; s < 2; ++s) { pf[kt][s].x = pk2(p[8 * s + 0], p[8 * s + 1]); pf[kt][s].y = pk2(p[8 * s + 2], p[8 * s + 3]); pf[kt][s].z = pk2(p[8 * s + 4], p[8 * s + 5]); pf[kt][s].w = pk2(p[8 * s + 6], p[8 * s + 7]); }
        }
        sum += __shfl_xor(sum, 32);
        __syncthreads();
#pragma unroll
        for (int i = 0; i < 12; ++i) *(LAS u32x4*)(lds + i * 8192 + loff) = vv[i];
        __syncthreads();
        f32x16 O[4];
#pragma unroll
        for (int c = 0; c < 4; ++c)
#pragma unroll
            for (int i = 0; i < 16; ++i) O[c][i] = 0.f;
        const unsigned blk = (lane >> 4) & 1, qq = (lane & 15) >> 2, pq = lane & 3;
        unsigned va[4][2];
#pragma unroll
        for (int c = 0; c < 4; ++c)
#pragma unroll
            for (int t = 0; t < 2; ++t) va[c][t] = (unsigned)(size_t)lds + wave * 8192 + off_b(8 * t + 4 * h + qq, 4 * c + 2 * blk + (pq >> 1)) + 8 * (pq & 1);
#pragma unroll
        for (int kt = 0; kt < 5; ++kt) {
            const int T = qt + kt - 2; const bool tv = (T >= 0) && (T < ntile);
            if (tv) {
                u16x4 t00, t01, t10, t11, t20, t21, t30, t31, u00, u01, u10, u11, u20, u21, u30, u31;
                asm volatile("s_waitcnt lgkmcnt(0)\n\t"
                             "ds_read_b64_tr_b16 %0, %16\n\tds_read_b64_tr_b16 %1, %17\n\tds_read_b64_tr_b16 %2, %18\n\tds_read_b64_tr_b16 %3, %19\n\t"
                             "ds_read_b64_tr_b16 %4, %20\n\tds_read_b64_tr_b16 %5, %21\n\tds_read_b64_tr_b16 %6, %22\n\tds_read_b64_tr_b16 %7, %23\n\t"
                             "ds_read_b64_tr_b16 %8, %16 offset:4096\n\tds_read_b64_tr_b16 %9, %17 offset:4096\n\tds_read_b64_tr_b16 %10, %18 offset:4096\n\tds_read_b64_tr_b16 %11, %19 offset:4096\n\t"
                             "ds_read_b64_tr_b16 %12, %20 offset:4096\n\tds_read_b64_tr_b16 %13, %21 offset:4096\n\tds_read_b64_tr_b16 %14, %22 offset:4096\n\tds_read_b64_tr_b16 %15, %23 offset:4096\n\t"
                             "s_waitcnt lgkmcnt(0)"
                             : "=&v"(t00), "=&v"(t01), "=&v"(t10), "=&v"(t11), "=&v"(t20), "=&v"(t21), "=&v"(t30), "=&v"(t31),
                               "=&v"(u00), "=&v"(u01), "=&v"(u10), "=&v"(u11), "=&v"(u20), "=&v"(u21), "=&v"(u30), "=&v"(u31)
                             : "v"(va[0][0] + kt * 8192), "v"(va[0][1] + kt * 8192), "v"(va[1][0] + kt * 8192), "v"(va[1][1] + kt * 8192),
                               "v"(va[2][0] + kt * 8192), "v"(va[2][1] + kt * 8192), "v"(va[3][0] + kt * 8192), "v"(va[3][1] + kt * 8192) : "memory");
                const bf16x8 p0 = __builtin_bit_cast(bf16x8, pf[kt][0]), p1 = __builtin_bit_cast(bf16x8, pf[kt][1]);
                O[0] = MFMA32(cat4(t00, t01), p0, O[0]); O[1] = MFMA32(cat4(t10, t11), p0, O[1]); O[2] = MFMA32(cat4(t20, t21), p0, O[2]); O[3] = MFMA32(cat4(t30, t31), p0, O[3]);
                O[0] = MFMA32(cat4(u00, u01), p1, O[0]); O[1] = MFMA32(cat4(u10, u11), p1, O[1]); O[2] = MFMA32(cat4(u20, u21), p1, O[2]); O[3] = MFMA32(cat4(u30, u31), p1, O[3]);
            }
        }
        const float inv = 1.f / sum;
        bf16_t* op = OpB + (size_t)pat * MTOK * AW + qrow * AW + hh * 128 + 4 * h;
#pragma unroll
        for (int c = 0; c < 4; ++c)
#pragma unroll
            for (int g = 0; g < 4; ++g) { u32x2 w; w.x = pk2(O[c][4 * g] * inv, O[c][4 * g + 1] * inv); w.y = pk2(O[c][4 * g + 2] * inv, O[c][4 * g + 3] * inv);
                *(u32x2*)(op + 32 * c + 8 * g) = w; }
        if (h == 0) LseB[(size_t)pat * MTOK * 8 + qrow * 8 + hh] = (mx + __builtin_amdgcn_logf(sum)) * LN2F;
        __syncthreads();
#undef TILE_BASE
    }
}

__device__ __forceinline__ void phase_combine(const Params& P, int layer_i) {
    unsigned char* ws = P.ws; asm volatile("" : "+s"(ws));
    int tid_ = threadIdx.x; asm volatile("" : "+v"(tid_));
    const int tid2 = tid_;
    const bf16_t* sza = (const bf16_t*)(ws + WS_SZA); const bf16_t* pp = (const bf16_t*)(ws + WS_PP); const bf16_t* gz = (const bf16_t*)(ws + WS_GZ);
    const bf16_t* Op = (const bf16_t*)(ws + WS_OP); const float* Lse = (const float*)(ws + WS_LSE); bf16_t* Y = (bf16_t*)(ws + WS_H);
    const float* cw = inp(P, I_AB_CONV) + (size_t)layer_i * 3 * AW;
    for (int item = blockIdx.x; item < NB * 8 * 8; item += gridDim.x) {
        const int b = item >> 6, hh = (item >> 3) & 7, seg = item & 7, s0 = seg * 512;
        const int cl = tid2 & 15, col = hh * 128 + cl * 8;
        float w0[8], w1[8], w2[8];
#pragma unroll
        for (int e = 0; e < 8; ++e) { w0[e] = cw[col + e]; w1[e] = cw[AW + col + e]; w2[e] = cw[2 * AW + col + e]; }
#pragma unroll 2
        for (int pass = 0; pass < 16; ++pass) {
            const int pos = s0 + pass * 32 + (tid2 >> 4); const size_t row = (size_t)b * SEQ + pos;
            const float l0 = Lse[row * 8 + hh], l1 = Lse[(size_t)MTOK * 8 + row * 8 + hh], l2 = Lse[(size_t)2 * MTOK * 8 + row * 8 + hh];
            const float lm = fmaxf(l0, fmaxf(l1, l2));
            float e0 = fexp2((l0 - lm) * 1.4426950408889634f), e1 = fexp2((l1 - lm) * 1.4426950408889634f), e2 = fexp2((l2 - lm) * 1.4426950408889634f);
            const float ei = 1.f / (e0 + e1 + e2); e0 *= ei; e1 *= ei; e2 *= ei;
            const u32x4 a0 = *(const u32x4*)(Op + row * AW + col), a1 = *(const u32x4*)(Op + (size_t)MTOK * AW + row * AW + col), a2 = *(const u32x4*)(Op + (size_t)2 * MTOK * AW + row * AW + col);
            const u32x4 zz = *(const u32x4*)(sza + row * AW + col);
            u32x4 ya;
#pragma unroll
            for (int e = 0; e < 4; ++e) {
                const float lo = (e0 * bf_lo(a0[e]) + e1 * bf_lo(a1[e]) + e2 * bf_lo(a2[e])) * bf_lo(zz[e]);
                const float hi = (e0 * bf_hi(a0[e]) + e1 * bf_hi(a1[e]) + e2 * bf_hi(a2[e])) * bf_hi(zz[e]);
                ya[e] = pk2(lo, hi); }
            *(u32x4*)(Y + row * DM + col) = ya;
            const u32x4 pc = *(const u32x4*)(pp + row * AW + col);
            u32x4 pm = (u32x4){0u, 0u, 0u, 0u}, pn = (u32x4){0u, 0u, 0u, 0u};
            if (pos > 0) pm = *(const u32x4*)(pp + (row - 1) * AW + col);
            if (pos < SEQ - 1) pn = *(const u32x4*)(pp + (row + 1) * AW + col);
            const u32x4 gg = *(const u32x4*)(gz + row * AW + col);
            u32x4 yb;
#pragma unroll
            for (int e = 0; e < 4; ++e) {
                const float lo = bf_lo(gg[e]) * (w0[2 * e] * bf_lo(pm[e]) + w1[2 * e] * bf_lo(pc[e]) + w2[2 * e] * bf_lo(pn[e]));
                const float hi = bf_hi(gg[e]) * (w0[2 * e + 1] * bf_hi(pm[e]) + w1[2 * e + 1] * bf_hi(pc[e]) + w2[2 * e + 1] * bf_hi(pn[e]));
                yb[e] = pk2(lo, hi); }
            *(u32x4*)(Y + row * DM + AW + col) = yb;
        }
    }
}

constexpr int SG_A = 0, SG_B = 32768, SG_MIX_STRIDE = 1040, SG_STATS = 128 * SG_MIX_STRIDE;
__device__ __forceinline__ void phase_sgu(const Params& P, LAS unsigned char* lds, int layer_i) {
    unsigned char* ws = P.ws; asm volatile("" : "+s"(ws));
    int tid_ = threadIdx.x; asm volatile("" : "+v"(tid_));
    const int tid = tid_, lane = tid & 63, wave = __builtin_amdgcn_readfirstlane(tid >> 6);
    const bf16_t* uz = (const bf16_t*)(ws + WS_UZ); const bf16_t* gv = (const bf16_t*)(ws + WS_GV); const float* stats = (const float*)(ws + WS_STATS);
    const bf16_t* wsb = (const bf16_t*)(ws + WS_WS) + (size_t)layer_i * 8 * 128 * 128;
    const float* lng = inp(P, I_SG_LNG) + layer_i * DM; const float* lnb = inp(P, I_SG_LNB) + layer_i * DM; const float* bs = inp(P, I_SG_BS) + layer_i * 8 * 128;
    bf16_t* Y = (bf16_t*)(ws + WS_H);
    LAS float* st = (LAS float*)(lds + SG_STATS);
    const unsigned lbase = (unsigned)(size_t)lds;
    for (int item = blockIdx.x; item < (MTOK / 128) * 8; item += gridDim.x) {
        const int cn = item >> 3, g = item & 7; const size_t row0 = (size_t)cn * 128;
        { const int rr = tid >> 2, part = tid & 3; const float2* sp = (const float2*)stats + (row0 + rr) * 32 + part * 8; float s1 = 0.f, s2 = 0.f;
#pragma unroll
          for (int i = 0; i < 8; ++i) { const float2 v = sp[i]; s1 += v.x; s2 += v.y; }
          s1 += __shfl_xor(s1, 1); s2 += __shfl_xor(s2, 1); s1 += __shfl_xor(s1, 2); s2 += __shfl_xor(s2, 2);
          const float mu = s1 * (1.f / DM), var = fmaxf(s2 * (1.f / DM) - mu * mu, 0.f);
          if (part == 0) { st[2 * rr] = mu; st[2 * rr + 1] = 1.f / sqrtf(var + 1e-6f); } }
#pragma unroll
        for (int i = 0; i < 4; ++i) { const int n = tid + 512 * i, row = n >> 4, ch = n & 15;
            *(LAS u32x4*)(lds + SG_A + off_b(row, ch)) = *(const u32x4*)(wsb + ((size_t)g * 128 + row) * 128 + ch * 8); }
        __syncthreads();
#pragma unroll
        for (int i = 0; i < 8; ++i) { const int n = tid + 512 * i, row = n >> 5, cc = n & 31, c0 = g * 256 + cc * 8;
            const u32x4 v = *(const u32x4*)(gv + (row0 + row) * DM + c0);
            const float mu = st[2 * row], rs = st[2 * row + 1];
            const f32x4 g0 = *(const f32x4*)(lng + c0), g1 = *(const f32x4*)(lng + c0 + 4), b0 = *(const f32x4*)(lnb + c0), b1 = *(const f32x4*)(lnb + c0 + 4);
            u32x4 o;
            o.x = pk2((bf_lo(v.x) - mu) * rs * g0.x + b0.x, (bf_hi(v.x) - mu) * rs * g0.y + b0.y); o.y = pk2((bf_lo(v.y) - mu) * rs * g0.z + b0.z, (bf_hi(v.y) - mu) * rs * g0.w + b0.w);
            o.z = pk2((bf_lo(v.z) - mu) * rs * g1.x + b1.x, (bf_hi(v.z) - mu) * rs * g1.y + b1.y); o.w = pk2((bf_lo(v.w) - mu) * rs * g1.z + b1.z, (bf_hi(v.w) - mu) * rs * g1.w + b1.w);
            *(LAS u32x4*)(lds + SG_B + (cc >> 4) * 32768 + off_b(row, cc & 15)) = o; }
        __syncthreads();
        const unsigned h = lane >> 5, blk = (lane >> 4) & 1, qq = (lane & 15) >> 2, pp = lane & 3;
        const unsigned bimg = lbase + SG_B + (wave >> 2) * 32768; const int ct = wave & 3;
        bf16x8 bf[8];
#pragma unroll
        for (int ks = 0; ks < 8; ++ks) {
            const u16x4 t0 = tr_read(bimg + off_b(16 * ks + 8 * h + qq, 4 * ct + 2 * blk + (pp >> 1)) + 8 * (pp & 1));
            const u16x4 t1 = tr_read(bimg + off_b(16 * ks + 8 * h + 4 + qq, 4 * ct + 2 * blk + (pp >> 1)) + 8 * (pp & 1));
            bf[ks] = cat4(t0, t1); }
        f32x16 acc[4];
#pragma unroll
        for (int tt = 0; tt < 4; ++tt) {
#pragma unroll
            for (int i = 0; i < 16; ++i) acc[tt][i] = 0.f;
#pragma unroll
            for (int ks = 0; ks < 8; ++ks) { const bf16x8 af = *(const LAS bf16x8*)(lds + SG_A + off_b(32 * tt + (lane & 31), 2 * ks + h)); acc[tt] = MFMA32(af, bf[ks], acc[tt]); }
        }
        __syncthreads();
#pragma unroll
        for (int tt = 0; tt < 4; ++tt)
#pragma unroll
            for (int i = 0; i < 16; ++i) { const int t = 32 * tt + (i & 3) + 8 * (i >> 2) + 4 * h;
                *(LAS float*)(lds + t * SG_MIX_STRIDE + (32 * wave + (lane & 31)) * 4) = acc[tt][i] + bs[g * 128 + t]; }
        __syncthreads();
#pragma unroll
        for (int i = 0; i < 8; ++i) { const int n = tid + 512 * i, row = n >> 5, cc = n & 31;
            const f32x4 m0 = *(const LAS f32x4*)(lds + row * SG_MIX_STRIDE + cc * 32), m1 = *(const LAS f32x4*)(lds + row * SG_MIX_STRIDE + cc * 32 + 16);
            const size_t o = (row0 + row) * DM + g * 256 + cc * 8;
            const u32x4 u = *(const u32x4*)(uz + o);
            u32x4 y; y.x = pk2(bf_lo(u.x) * m0.x, bf_hi(u.x) * m0.y); y.y = pk2(bf_lo(u.y) * m0.z, bf_hi(u.y) * m0.w); y.z = pk2(bf_lo(u.z) * m1.x, bf_hi(u.z) * m1.y); y.w = pk2(bf_lo(u.w) * m1.z, bf_hi(u.w) * m1.w);
            *(u32x4*)(Y + o) = y; }
        __syncthreads();
    }
}

#define XB_TMO      128
#define XB_XCNT(j)  (256  + 64 * (j))
#define XB_XSUB(j)  (1280 + 64 * (j))
#define XB_XGEN(j)  (2304 + 64 * (j))
#define XB_TOP      3328
#define XB_TOPGEN   3392
#define XCD_BAR_WORDS 3456
#define XB_SPIN_CAP (1u << 23)

__device__ __forceinline__ unsigned xb_ld(unsigned* p)              { return __hip_atomic_load(p, __ATOMIC_RELAXED, __HIP_MEMORY_SCOPE_AGENT); }
__device__ __forceinline__ unsigned xb_add(unsigned* p, unsigned v) { return __hip_atomic_fetch_add(p, v, __ATOMIC_RELAXED, __HIP_MEMORY_SCOPE_AGENT); }
__device__ __forceinline__ unsigned xb_xcc_id() { return (unsigned)__builtin_amdgcn_s_getreg((3 << 11) | 20) & 0xFu; }
#define XB_SPIN(cond, bar) do { unsigned _sp = 0; while (cond) { __builtin_amdgcn_s_sleep(1); \
    if ((++_sp & 255u) == 0u) { if (xb_ld(&(bar)[XB_TMO])) break; if (_sp > XB_SPIN_CAP) { atomicAdd(&(bar)[XB_TMO], 1u); break; } } } } while (0)

struct XcdBarrier {
    unsigned* bar; unsigned x;
    volatile LAS unsigned* st;
};

__device__ __forceinline__ XcdBarrier xcd_barrier_post(unsigned* bar, volatile LAS unsigned* st) {
    XcdBarrier b; b.bar = bar; b.x = xb_xcc_id(); b.st = st;
    if (threadIdx.x == 0) (void)xb_add(&bar[XB_XCNT(b.x)], 1u);
    return b;
}
__device__ __forceinline__ void xcd_barrier_complete(unsigned* bar, unsigned x, unsigned& nloc, unsigned& nx) {
    const unsigned G = gridDim.x * gridDim.y * gridDim.z;
    unsigned sum, cnt, mine, sp = 0u;
    for (;;) {
        sum = 0u; cnt = 0u; mine = 0u;
#pragma unroll
        for (unsigned j = 0; j < 16; ++j) { const unsigned c = xb_ld(&bar[XB_XCNT(j)]); sum += c; cnt += (c > 0u) ? 1u : 0u; mine = (j == x) ? c : mine; }
        if (sum == G) break;
        __builtin_amdgcn_s_sleep(1);
        if ((++sp & 255u) == 0u) { if (xb_ld(&bar[XB_TMO])) break; if (sp > XB_SPIN_CAP) { atomicAdd(&bar[XB_TMO], 1u); break; } }
    }
    nloc = mine > 0u ? mine : 1u; nx = cnt > 0u ? cnt : 1u;
}

__device__ __forceinline__ void xcd_barrier(const XcdBarrier& b) {
    asm volatile("s_waitcnt vmcnt(0)" ::: "memory");
    __syncthreads();
    if (threadIdx.x == 0) {
        unsigned* bar = b.bar;
        __builtin_amdgcn_s_waitcnt(0);
        unsigned nloc = b.st[0], nx = b.st[1];
        if (nloc == 0u) { xcd_barrier_complete(bar, b.x, nloc, nx); b.st[0] = nloc; b.st[1] = nx; }
        const unsigned old = xb_add(&bar[XB_XSUB(b.x)], 1u);
        const unsigned gen = old / nloc;
        if (old + 1u == (gen + 1u) * nloc) {
            __builtin_amdgcn_fence(__ATOMIC_RELEASE, "agent");
            asm volatile("s_waitcnt vmcnt(0)" ::: "memory");
            const unsigned og = xb_add(&bar[XB_TOP], 1u);
            const unsigned tg = og / nx;
            if (og + 1u == (tg + 1u) * nx) xb_add(&bar[XB_TOPGEN], 1u);
            else XB_SPIN(xb_ld(&bar[XB_TOPGEN]) == tg, bar);
            __builtin_amdgcn_fence(__ATOMIC_ACQUIRE, "agent");
            xb_add(&bar[XB_XGEN(b.x)], 1u);
            asm volatile("s_waitcnt vmcnt(0)" ::: "memory");
        } else {
            XB_SPIN(xb_ld(&bar[XB_XGEN(b.x)]) == gen, bar);
            __builtin_amdgcn_fence(__ATOMIC_ACQUIRE, "agent");
            asm volatile("s_waitcnt vmcnt(0)" ::: "memory");
        }
    }
    __syncthreads();
}


template <class Epi> __device__ __forceinline__ void run_gemm(LAS unsigned char* lds, const bf16_t* A, const bf16_t* Bt, int N, const Epi& E, int pm_mask = -1) {
    pg8::Gemm g; g.A = A; g.Bt = Bt; g.M = MTOK; g.N = N; g.K = DM; g.pm_mask = pm_mask;
    pg8::StaticOrder S; S.init(MTOK, N, (int)gridDim.x, (int)blockIdx.x);
    pg8::gemm_phase<Epi, pg8::StaticOrder, true, true>(lds, g, S, E);
}
__global__ __launch_bounds__(512, 2) void mega_fwd(Params P) {
    extern __shared__ __attribute__((aligned(16))) unsigned char shm[];
    LAS unsigned char* lds = (LAS unsigned char*)shm;
    cg::grid_group grid = cg::this_grid();
    volatile LAS unsigned* xst = (volatile LAS unsigned*)(lds + LDS_XB);
    if (threadIdx.x == 0) { xst[0] = 0u; xst[1] = 0u; }
    __syncthreads();
    XcdBarrier xb = xcd_barrier_post((unsigned*)(P.ws + WS_BAR), xst);
    int nsync = 0;
#ifndef PROBE_REP
#define PROBE_REP 0
#endif
#ifndef PROBE_AI
#define PROBE_AI 1
#endif
#ifndef PROBE_AC
#define PROBE_AC 1
#endif
#ifndef PROBE_SYNCS
#define PROBE_SYNCS 0
#endif
    for (int i = 0; i < PROBE_SYNCS; ++i) xcd_barrier(xb);
    for (int ph2 = 2 * P.ph_lo; ph2 < 2 * P.ph_hi; ++ph2) {
        const int ph = ph2 >> 1;
        if (ph2 & 1) {
            const int sub_ = (ph - 1) & 3, L_ = (ph - 1) >> 2; bool rep = false;
            if (ph >= 1 && ph <= 16) { if (sub_ == 0) rep = (PROBE_REP & 1) && L_ == 0; else if (sub_ == 1) rep = PROBE_REP & 2; else if (sub_ == 2) rep = (L_ & 1) ? (PROBE_REP & 8) : (PROBE_REP & 4); else rep = PROBE_REP & 32; }
            if (!rep) continue;
        }
        if (ph2 > 2 * P.ph_lo) { if (P.ph_hi > 1000) grid.sync(); else xcd_barrier(xb); ++nsync; }
        unsigned char* ws = P.ws; asm volatile("" : "+s"(ws));
        float* xbuf = P.out; asm volatile("" : "+s"(xbuf));
        float* mod = (float*)(ws + WS_MOD);
        bf16_t* H = (bf16_t*)(ws + WS_H);
        if (ph == 0) {
#ifndef SKIP_PRO
            phase_prologue(P, lds);
#endif
            continue; }
        if (ph == 17) { phase_final((const _Float16*)xbuf, (const bf16_t*)(ws + WS_DL), inp(P, I_FNG), xbuf); continue; }
        const int L = (ph - 1) >> 2, sub = (ph - 1) & 3, li = L >> 1; const bool sg = L & 1;
        const float* modL = mod + (size_t)L * 4 * 6144;
        if (sub == 0) { phase_norm(inp(P, I_X), L < 2 ? nullptr : (const _Float16*)xbuf, L == 0 ? nullptr : (const bf16_t*)(ws + WS_DL), L == 0 ? nullptr : (_Float16*)xbuf, (sg ? inp(P, I_SG_NG) : inp(P, I_AB_NG)) + li * DM, modL, H); }
        else if (sub == 1) {
            if (!sg) { EpiAB1 E; E.q = (bf16_t*)(ws + WS_Q); E.k = (bf16_t*)(ws + WS_K); E.v = (bf16_t*)(ws + WS_V); E.sza = (bf16_t*)(ws + WS_SZA); E.pp = (bf16_t*)(ws + WS_PP); E.gz = (bf16_t*)(ws + WS_GZ);
                E.cosT = (const float*)(ws + WS_ROPE); E.sinT = E.cosT + 4096 * 64;

#ifndef SKIP_G1
                run_gemm(lds, H, (const bf16_t*)(ws + WS_WAB_IN + li * SZ_WAB_IN), N_AB, E);
#endif
            }
            else { EpiSG1 E; E.uz = (bf16_t*)(ws + WS_UZ); E.gv = (bf16_t*)(ws + WS_GV); E.stats = (float*)(ws + WS_STATS);

#ifndef SKIP_G2
                run_gemm(lds, H, (const bf16_t*)(ws + WS_WSG_IN + li * SZ_WSG_IN), N_SG, E);
#endif
            }
        } else if (sub == 2) { if (!sg) {
#ifndef SKIP_ATTN
                for (int rep_ = 0; rep_ < PROBE_AI; ++rep_) phase_attn_items(P, lds);
                xcd_barrier(xb);
                for (int rep_ = 0; rep_ < PROBE_AC; ++rep_) phase_combine(P, li);
#endif
            } else {
#ifndef SKIP_SGU
                phase_sgu(P, lds, li);
#endif
            } }
        else { EpiDelta E; E.dl = (bf16_t*)(ws + WS_DL); E.gate = modL + 4096;
#ifdef PROBE_NOSTORE
            if (ph2 & 1) E.dl = nullptr;
#endif

#ifndef SKIP_G3
#ifdef PROBE_NOSTORE
            run_gemm(lds, H, (const bf16_t*)(ws + (sg ? WS_WSG_OUT : WS_WAB_OUT) + li * SZ_WOUT), DM, E, (ph2 & 1) ? PROBE_PMMASK : -1);
#else
            run_gemm(lds, H, (const bf16_t*)(ws + (sg ? WS_WSG_OUT : WS_WAB_OUT) + li * SZ_WOUT), DM, E);
#endif
#endif
        }
    }
}

#ifndef N_LAUNCH_MODE
#define N_LAUNCH_MODE 1
#endif
extern "C" void kernel_launch(void* const* d_in, const int* in_sizes, int n_in, void* d_out, int out_size, void* d_ws, size_t ws_size, hipStream_t stream) {
    static int grid = 0;
    if (grid == 0) {
        if (n_in != 18 || out_size != MTOK * DM || ws_size < WS_END) { fprintf(stderr, "kernel_launch: unexpected shapes (n_in %d, out %d, ws %zu, need %zu)\n", n_in, out_size, ws_size, (size_t)WS_END); grid = -1; return; }
        int dev = 0, cus = 0, per_cu = 0;
        (void)hipGetDevice(&dev); (void)hipDeviceGetAttribute(&cus, hipDeviceAttributeMultiprocessorCount, dev);
        if (hipFuncSetAttribute((const void*)mega_fwd, hipFuncAttributeMaxDynamicSharedMemorySize, LDS_BYTES) != hipSuccess) { fprintf(stderr, "kernel_launch: hipFuncSetAttribute failed\n"); grid = -1; return; }
        if (hipOccupancyMaxActiveBlocksPerMultiprocessor(&per_cu, (const void*)mega_fwd, NTHR, LDS_BYTES) != hipSuccess || per_cu < 1) { fprintf(stderr, "kernel_launch: occupancy query says %d\n", per_cu); per_cu = 1; }
        (void)hipGetLastError();
        grid = cus * 1;
    }
    if (grid < 0) return;
    (void)hipMemsetAsync((unsigned char*)d_ws + WS_MOD, 0, SZ_MOD + SZ_BAR, stream);
    Params p{};
    for (int i = 0; i < 18; ++i) p.in[i] = (const float*)d_in[i];
    p.out = (float*)d_out; p.ws = (unsigned char*)d_ws;
#if N_LAUNCH_MODE == 1
    p.ph_lo = 0; p.ph_hi = 18;
    void* args[] = {&p};
    hipError_t e = hipLaunchCooperativeKernel((const void*)mega_fwd, dim3(grid), dim3(NTHR), args, LDS_BYTES, stream);
    if (e != hipSuccess) fprintf(stderr, "cooperative launch failed: %s (grid %d)\n", hipGetErrorString(e), grid);
#else
    for (int ph = 0; ph < 18; ++ph) { p.ph_lo = ph; p.ph_hi = ph + 1; hipLaunchKernelGGL(mega_fwd, dim3(grid), dim3(NTHR), LDS_BYTES, stream, p); }
#endif
}
```
